# Optimizing an MI355X kernel written in HIP

```python
import math
import jax
import jax.numpy as jnp
from jax import lax
import numpy as np


D_MODEL = 1024
BATCH = 8
SEQ = 8192
DEPTH = 2

MEM_LEN = 256
N_BRANCH = 4
MIX_W = D_MODEL // N_BRANCH
N_IN_SPLITS = 11
IN_COLS = N_IN_SPLITS * MIX_W
HG_HEADS = 4
HG_DH = MIX_W // HG_HEADS
HG_CHUNK = 32
RET_HEADS = 4
RET_DH = MIX_W // RET_HEADS
RET_CHUNK = 128
ROPE_BASE = 10000.0
LRU_BLOCKS = 4
LRU_BS = MIX_W // LRU_BLOCKS
CONV_W = 4
LRU_C = 8.0
S5_GROUP = 16
S5_GROUPS = MIX_W // S5_GROUP
S5_STATE = 64
XA_HEADS = 4
XA_DH = D_MODEL // XA_HEADS
D_FF = -(-8 * D_MODEL // (3 * 256)) * 256
EPS = 1e-6

kernel_name = 'hybrid_gated_hgrn2_retention_rglru_s5_block'


def rms_norm(x, g):
    xf = x.astype(jnp.float32)
    y = xf * lax.rsqrt(jnp.mean(xf * xf, axis=-1, keepdims=True) + EPS)
    return (y * g.astype(jnp.float32)).astype(x.dtype)


def _head_rms(o, n_heads, g):
    B_, S_, W_ = o.shape
    oh = o.reshape(B_, S_, n_heads, W_ // n_heads)
    oh = oh * lax.rsqrt(jnp.mean(oh * oh, axis=-1, keepdims=True) + EPS)
    return oh.reshape(B_, S_, W_) * g.astype(jnp.float32)


def _to_chunks(t, n_heads, chunk):
    B_, S_, W_ = t.shape
    return t.reshape(B_, S_ // chunk, chunk, n_heads, W_ // n_heads).transpose(0, 3, 1, 2, 4)


def _from_chunks(o):
    B_, H_, N_, C_, d_ = o.shape
    return o.transpose(0, 2, 3, 1, 4).reshape(B_, N_ * C_, H_ * d_)


def _inter_chunk(q_dec, k_end, v, decay_end):
    def step(state, inp):
        qn, kn, vn, dn = inp
        o = jnp.einsum('bhck,bhkv->bhcv', qn, state)
        state = dn[..., None] * state + jnp.einsum('bhck,bhcv->bhkv', kn, vn)
        return state, o
    xs = (jnp.moveaxis(q_dec, 2, 0), jnp.moveaxis(k_end, 2, 0),
          jnp.moveaxis(v, 2, 0), jnp.moveaxis(decay_end, 2, 0))
    B_, H_, _, _, K_ = q_dec.shape
    s0 = jnp.zeros((B_, H_, K_, v.shape[-1]), jnp.float32)
    _, o = lax.scan(step, s0, xs)
    return jnp.moveaxis(o, 0, 2)


def hgrn2_mixer(q, f_logit, i, g, lb, norm_g):
    dt = q.dtype
    q, f_logit, i, g = (t.astype(jnp.float32) for t in (q, f_logit, i, g))
    lb = lb.astype(jnp.float32)
    f = lb + (1.0 - lb) * jax.nn.sigmoid(f_logit)
    log_f = jnp.log(f)
    k = 1.0 - f
    q = jax.nn.silu(q)
    qc, kc, vc, lfc = (_to_chunks(t, HG_HEADS, HG_CHUNK) for t in (q, k, i, log_f))
    b = jnp.cumsum(lfc, axis=3)
    b_end = b[..., -1:, :]
    q_dec = qc * jnp.exp(b)
    k_inv = kc * jnp.exp(-b)
    k_end = kc * jnp.exp(b_end - b)
    causal = jnp.tril(jnp.ones((HG_CHUNK, HG_CHUNK), dtype=bool))
    scores = jnp.where(causal, jnp.einsum('bhnck,bhnsk->bhncs', q_dec, k_inv), 0.0)
    o = jnp.einsum('bhncs,bhnsv->bhncv', scores, vc)
    o = o + _inter_chunk(q_dec, k_end, vc, jnp.exp(b_end[..., 0, :]))
    o = _head_rms(_from_chunks(o), HG_HEADS, norm_g) * jax.nn.silu(g)
    return o.astype(dt)


def _rotate(t, cos, sin):
    t1 = t[..., 0::2]
    t2 = t[..., 1::2]
    c = cos[None, :, None, :]
    s = sin[None, :, None, :]
    return jnp.stack([t1 * c - t2 * s, t1 * s + t2 * c], axis=-1).reshape(t.shape)


def retention_mixer(q, k, v, g, norm_g):
    dt = q.dtype
    q, k, v, g = (t.astype(jnp.float32) for t in (q, k, v, g))
    B_, S_, _ = q.shape
    pos = jnp.arange(S_, dtype=jnp.float32)
    inv_freq = ROPE_BASE ** (-jnp.arange(0, RET_DH, 2, dtype=jnp.float32) / RET_DH)
    ang = pos[:, None] * inv_freq[None, :]
    cos, sin = jnp.cos(ang), jnp.sin(ang)
    q = _rotate(q.reshape(B_, S_, RET_HEADS, RET_DH), cos, sin).reshape(B_, S_, MIX_W)
    k = _rotate(k.reshape(B_, S_, RET_HEADS, RET_DH), cos, sin).reshape(B_, S_, MIX_W) * (RET_DH ** -0.5)
    log_gamma = jnp.log1p(-jnp.power(2.0, -5.0 - jnp.arange(RET_HEADS, dtype=jnp.float32)))
    idx = jnp.arange(RET_CHUNK, dtype=jnp.float32)
    rel = idx[:, None] - idx[None, :]
    causal = rel >= 0
    decay = jnp.where(causal, jnp.exp(jnp.where(causal, rel, 0.0)[None] * log_gamma[:, None, None]), 0.0)
    qc, kc, vc = (_to_chunks(t, RET_HEADS, RET_CHUNK) for t in (q, k, v))
    scores = jnp.einsum('bhncd,bhnsd->bhncs', qc, kc) * decay[None, :, None]
    o = jnp.einsum('bhncs,bhnsv->bhncv', scores, vc)
    xi = jnp.exp((idx + 1.0)[None, :] * log_gamma[:, None])
    zeta = jnp.exp((RET_CHUNK - 1.0 - idx)[None, :] * log_gamma[:, None])
    g_end = jnp.exp(RET_CHUNK * log_gamma)
    q_x = qc * xi[None, :, None, :, None]
    k_z = kc * zeta[None, :, None, :, None]
    N_ = qc.shape[2]
    decay_end = jnp.broadcast_to(g_end[None, :, None, None], (B_, RET_HEADS, N_, RET_DH))
    o = o + _inter_chunk(q_x, k_z, vc, decay_end)
    o = _head_rms(_from_chunks(o), RET_HEADS, norm_g) * jax.nn.silu(g)
    return o.astype(dt)


def _linear_combine(e1, e2):
    a1, b1 = e1
    a2, b2 = e2
    return a1 * a2, a2 * b1 + b2


def rglru_mixer(x_gate, x_in, conv_w, conv_b, wa, ba, wx, bx, lam):
    dt = x_in.dtype
    xg = x_gate.astype(jnp.float32)
    xi = x_in.astype(jnp.float32)
    B_, S_, _ = xi.shape
    xc = lax.conv_general_dilated(
        xi, conv_w.astype(jnp.float32)[:, None, :], window_strides=(1,),
        padding=[(CONV_W - 1, 0)], dimension_numbers=('NWC', 'WIO', 'NWC'),
        feature_group_count=MIX_W) + conv_b.astype(jnp.float32)
    xb = xc.reshape(B_, S_, LRU_BLOCKS, LRU_BS)
    r = jax.nn.sigmoid(jnp.einsum('bsni,nij->bsnj', xb, wa.astype(jnp.float32)).reshape(B_, S_, MIX_W) + ba.astype(jnp.float32))
    ig = jax.nn.sigmoid(jnp.einsum('bsni,nij->bsnj', xb, wx.astype(jnp.float32)).reshape(B_, S_, MIX_W) + bx.astype(jnp.float32))
    log_a = -LRU_C * r * jax.nn.softplus(-lam.astype(jnp.float32))
    a = jnp.exp(log_a)
    u = jnp.sqrt(-jnp.expm1(2.0 * log_a)) * (ig * xc)
    _, h = lax.associative_scan(_linear_combine, (a, u), axis=1)
    return (h * jax.nn.gelu(xg)).astype(dt)


def _complex_combine(e1, e2):
    ar1, ai1, br1, bi1 = e1
    ar2, ai2, br2, bi2 = e2
    ar = ar1 * ar2 - ai1 * ai2
    ai = ar1 * ai2 + ai1 * ar2
    br = ar2 * br1 - ai2 * bi1 + br2
    bi = ar2 * bi1 + ai2 * br1 + bi2
    return ar, ai, br, bi


def s5_mixer(u, lam_re, lam_im, b_re, b_im, c_re, c_im, d, log_dt, glu_w, glu_b):
    dt_ = u.dtype
    uf = u.astype(jnp.float32)
    lam_re, lam_im, b_re, b_im, c_re, c_im, d, log_dt = (
        t.astype(jnp.float32) for t in (lam_re, lam_im, b_re, b_im, c_re, c_im, d, log_dt))
    B_, S_, _ = uf.shape
    step = jnp.exp(log_dt)[:, None]
    mag = jnp.exp(lam_re * step)
    lb_re = mag * jnp.cos(lam_im * step)
    lb_im = mag * jnp.sin(lam_im * step)
    den = lam_re * lam_re + lam_im * lam_im
    f_re = ((lb_re - 1.0) * lam_re + lb_im * lam_im) / den
    f_im = (lb_im * lam_re - (lb_re - 1.0) * lam_im) / den
    bb_re = f_re[..., None] * b_re - f_im[..., None] * b_im
    bb_im = f_re[..., None] * b_im + f_im[..., None] * b_re
    ug = uf.reshape(B_, S_, S5_GROUPS, S5_GROUP)
    bu_re = jnp.einsum('bsgp,gnp->bsgn', ug, bb_re)
    bu_im = jnp.einsum('bsgp,gnp->bsgn', ug, bb_im)
    a_re = jnp.broadcast_to(lb_re[None, None], (1, S_, S5_GROUPS, S5_STATE))
    a_im = jnp.broadcast_to(lb_im[None, None], (1, S_, S5_GROUPS, S5_STATE))
    _, _, h_re, h_im = lax.associative_scan(_complex_combine, (a_re, a_im, bu_re, bu_im), axis=1)
    y = jnp.einsum('bsgn,gpn->bsgp', h_re, c_re) - jnp.einsum('bsgn,gpn->bsgp', h_im, c_im)
    y = y.reshape(B_, S_, MIX_W) + d * uf
    act = jax.nn.gelu(y)
    out = act * jax.nn.sigmoid(act @ glu_w.astype(jnp.float32) + glu_b.astype(jnp.float32))
    return out.astype(dt_)


def mixer_block(h, lb, w_in, w_gate, b_gate, hg_norm, ret_norm, conv_w, conv_b, wa, ba, wx, bx, lam,
                lam_re, lam_im, b_re, b_im, c_re, c_im, s5_d, log_dt, glu_w, glu_b, w_up, w_out):
    B_, S_, _ = h.shape
    z = h @ w_in
    hq, hf, hi, hg, rq, rk, rv, rg, lgate, lx, su = jnp.split(z, N_IN_SPLITS, axis=-1)
    y_a = hgrn2_mixer(hq, hf, hi, hg, lb, hg_norm)
    y_b = retention_mixer(rq, rk, rv, rg, ret_norm)
    y_c = rglru_mixer(lgate, lx, conv_w, conv_b, wa, ba, wx, bx, lam)
    y_d = s5_mixer(su, lam_re, lam_im, b_re, b_im, c_re, c_im, s5_d, log_dt, glu_w, glu_b)
    branches = jnp.stack([y_a, y_b, y_c, y_d], axis=2)
    up = jnp.einsum('bsnc,ncd->bsnd', branches, w_up)
    gates = jax.nn.sigmoid(h @ w_gate + b_gate).reshape(B_, S_, N_BRANCH, D_MODEL)
    return jnp.sum(gates * up, axis=2) @ w_out


def cross_attention(h, m, w_q, w_kv, w_o):
    B_, S_, _ = h.shape
    M_ = m.shape[1]
    q = (h @ w_q).reshape(B_, S_, XA_HEADS, XA_DH)
    k, v = jnp.split(m @ w_kv, 2, axis=-1)
    k = k.reshape(B_, M_, XA_HEADS, XA_DH)
    v = v.reshape(B_, M_, XA_HEADS, XA_DH)
    s = jnp.einsum('bshd,bmhd->bhsm', q, k).astype(jnp.float32) * (XA_DH ** -0.5)
    p = jax.nn.softmax(s, axis=-1).astype(v.dtype)
    o = jnp.einsum('bhsm,bmhd->bshd', p, v).reshape(B_, S_, D_MODEL)
    return o @ w_o


def swiglu(h, w_gu, w_down):
    gate, up = jnp.split(h @ w_gu, 2, axis=-1)
    return (jax.nn.silu(gate) * up) @ w_down


def setup_inputs(seed: int = 0) -> dict:
    key = jax.random.key(seed)
    ks = iter(jax.random.split(key, 64))
    f32 = jnp.float32
    L, W, G, N, P = DEPTH, MIX_W, S5_GROUPS, S5_STATE, S5_GROUP

    def nrm(shape, scale):
        return jax.random.normal(next(ks), shape, f32) * scale

    def gain(shape):
        return 1.0 + 0.02 * jax.random.normal(next(ks), shape, f32)

    x = nrm((BATCH, SEQ, D_MODEL), 1.0)
    mem = nrm((BATCH, MEM_LEN, D_MODEL), 1.0)
    hg_lower_bounds = nrm((L, W), 0.5)
    norm_mix_pre = gain((L, D_MODEL))
    norm_mix_post = gain((L, D_MODEL))
    w_in = nrm((L, D_MODEL, IN_COLS), D_MODEL ** -0.5)
    w_gate = nrm((L, D_MODEL, N_BRANCH * D_MODEL), D_MODEL ** -0.5)
    b_gate = nrm((L, N_BRANCH * D_MODEL), 0.02)
    hg_norm = gain((L, W))
    ret_norm = gain((L, W))
    lru_conv_w = nrm((L, CONV_W, W), CONV_W ** -0.5)
    lru_conv_b = nrm((L, W), 0.02)
    lru_wa = nrm((L, LRU_BLOCKS, LRU_BS, LRU_BS), LRU_BS ** -0.5)
    lru_ba = nrm((L, W), 0.02)
    lru_wx = nrm((L, LRU_BLOCKS, LRU_BS, LRU_BS), LRU_BS ** -0.5)
    lru_bx = nrm((L, W), 0.02)
    a_c = jax.random.uniform(next(ks), (L, W), f32, minval=0.9, maxval=0.999)
    a_base = a_c ** (1.0 / LRU_C)
    lru_lambda = jnp.log(a_base) - jnp.log1p(-a_base)
    n_idx = jnp.arange(N, dtype=f32)
    s5_lam_re = -0.5 + 0.01 * jax.random.normal(next(ks), (L, G, N), f32)
    s5_lam_im = math.pi * n_idx[None, None, :] + 0.01 * jax.random.normal(next(ks), (L, G, N), f32)
    s5_b_re = nrm((L, G, N, P), (2.0 * P) ** -0.5)
    s5_b_im = nrm((L, G, N, P), (2.0 * P) ** -0.5)
    s5_c_re = nrm((L, G, P, N), (2.0 * N) ** -0.5 * 4.0)
    s5_c_im = nrm((L, G, P, N), (2.0 * N) ** -0.5 * 4.0)
    s5_d = nrm((L, W), 1.0)
    s5_log_dt = jax.random.uniform(next(ks), (L, G), f32, minval=math.log(1e-3), maxval=math.log(1e-1))
    s5_glu_w = nrm((L, W, W), W ** -0.5)
    s5_glu_b = nrm((L, W), 0.02)
    w_up = nrm((L, N_BRANCH, W, D_MODEL), W ** -0.5)
    w_out = nrm((L, D_MODEL, D_MODEL), D_MODEL ** -0.5)
    norm_xa_pre = gain((L, D_MODEL))
    norm_xa_post = gain((L, D_MODEL))
    norm_mem = gain((L, D_MODEL))
    xa_w_q = nrm((L, D_MODEL, D_MODEL), D_MODEL ** -0.5)
    xa_w_kv = nrm((L, D_MODEL, 2 * D_MODEL), D_MODEL ** -0.5)
    xa_w_o = nrm((L, D_MODEL, D_MODEL), D_MODEL ** -0.5)
    norm_ffn_pre = gain((L, D_MODEL))
    norm_ffn_post = gain((L, D_MODEL))
    ffn_w_gu = nrm((L, D_MODEL, 2 * D_FF), D_MODEL ** -0.5)
    ffn_w_down = nrm((L, D_FF, D_MODEL), D_FF ** -0.5)
    return {
        'x': x, 'mem': mem, 'hg_lower_bounds': hg_lower_bounds,
        'norm_mix_pre': norm_mix_pre, 'norm_mix_post': norm_mix_post,
        'w_in': w_in, 'w_gate': w_gate, 'b_gate': b_gate,
        'hg_norm': hg_norm, 'ret_norm': ret_norm,
        'lru_conv_w': lru_conv_w, 'lru_conv_b': lru_conv_b, 'lru_wa': lru_wa, 'lru_ba': lru_ba,
        'lru_wx': lru_wx, 'lru_bx': lru_bx, 'lru_lambda': lru_lambda,
        's5_lam_re': s5_lam_re, 's5_lam_im': s5_lam_im, 's5_b_re': s5_b_re, 's5_b_im': s5_b_im,
        's5_c_re': s5_c_re, 's5_c_im': s5_c_im, 's5_d': s5_d, 's5_log_dt': s5_log_dt,
        's5_glu_w': s5_glu_w, 's5_glu_b': s5_glu_b,
        'w_up': w_up, 'w_out': w_out,
        'norm_xa_pre': norm_xa_pre, 'norm_xa_post': norm_xa_post, 'norm_mem': norm_mem,
        'xa_w_q': xa_w_q, 'xa_w_kv': xa_w_kv, 'xa_w_o': xa_w_o,
        'norm_ffn_pre': norm_ffn_pre, 'norm_ffn_post': norm_ffn_post,
        'ffn_w_gu': ffn_w_gu, 'ffn_w_down': ffn_w_down,
    }


def reference(x, mem, hg_lower_bounds, norm_mix_pre, norm_mix_post, w_in, w_gate, b_gate,
              hg_norm, ret_norm, lru_conv_w, lru_conv_b, lru_wa, lru_ba, lru_wx, lru_bx, lru_lambda,
              s5_lam_re, s5_lam_im, s5_b_re, s5_b_im, s5_c_re, s5_c_im, s5_d, s5_log_dt,
              s5_glu_w, s5_glu_b, w_up, w_out, norm_xa_pre, norm_xa_post, norm_mem,
              xa_w_q, xa_w_kv, xa_w_o, norm_ffn_pre, norm_ffn_post, ffn_w_gu, ffn_w_down):
    p = jax.nn.softmax(hg_lower_bounds.astype(jnp.float32), axis=0)
    lower_bounds = jnp.cumsum(p, axis=0) - p[0:1]
    for l in range(DEPTH):
        h = rms_norm(x, norm_mix_pre[l])
        y = mixer_block(h, lower_bounds[l], w_in[l], w_gate[l], b_gate[l], hg_norm[l], ret_norm[l],
                        lru_conv_w[l], lru_conv_b[l], lru_wa[l], lru_ba[l], lru_wx[l], lru_bx[l], lru_lambda[l],
                        s5_lam_re[l], s5_lam_im[l], s5_b_re[l], s5_b_im[l], s5_c_re[l], s5_c_im[l],
                        s5_d[l], s5_log_dt[l], s5_glu_w[l], s5_glu_b[l], w_up[l], w_out[l])
        x = x + rms_norm(y, norm_mix_post[l])
        h = rms_norm(x, norm_xa_pre[l])
        m = rms_norm(mem, norm_mem[l])
        x = x + rms_norm(cross_attention(h, m, xa_w_q[l], xa_w_kv[l], xa_w_o[l]), norm_xa_post[l])
        h = rms_norm(x, norm_ffn_pre[l])
        x = x + rms_norm(swiglu(h, ffn_w_gu[l], ffn_w_down[l]), norm_ffn_post[l])
    return x
```

```cpp
#include <hip/hip_runtime.h>
#include <hip/hip_cooperative_groups.h>
#include <cstdio>
namespace cg = cooperative_groups;

#ifndef MAXPH
#define MAXPH 1000
#endif
#ifndef DUMPPH
#define DUMPPH 0
#endif
#ifndef PER_PHASE_LAUNCH
#define PER_PHASE_LAUNCH 0
#endif

#ifndef PMASK
#define PMASK 0xFFFFFFFFu
#endif
#define PEN(k) ((PMASK >> (k)) & 1u)
#define LAS __attribute__((address_space(3)))
typedef unsigned short bf16_t;
typedef short bf16x8 __attribute__((ext_vector_type(8)));
typedef float f32x2 __attribute__((ext_vector_type(2)));
typedef float f32x4 __attribute__((ext_vector_type(4)));
typedef float f32x16 __attribute__((ext_vector_type(16)));
typedef unsigned u32x4 __attribute__((ext_vector_type(4)));
typedef unsigned u32x2 __attribute__((ext_vector_type(2)));

constexpr int T = 65536, D = 1024, SEQ = 8192, INC = 2816, FF = 2816, NL = 2;
constexpr float EPS = 1e-6f;
#ifndef PROBE_MIX
#define PROBE_MIX 0
#endif
#if PROBE_MIX
constexpr int NSUB = 24;
__device__ __constant__ const int SPSEQ[NSUB] = {0, 1, 2, 3, 4, 5, 1, 2, 3, 4, 5, 6, 7, 8, 9, 10, 11, 12, 13, 14, 15, 16, 17, 18};
#else
constexpr int NSUB = 18;
__device__ __constant__ const int SPSEQ[NSUB] = {0, 1, 2, 3, 4, 6, 7, 8, 9, 10, 11, 12, 13, 14, 15, 16, 17, 18};
#endif
constexpr int NPH = 1 + NSUB * NL;

constexpr size_t MiB = (size_t)1 << 20;
constexpr size_t OW_IN = 0, OW_GATE = OW_IN + (size_t)INC * D * 2, OW_UP = OW_GATE + (size_t)4096 * D * 2, OW_OUT = OW_UP + (size_t)4096 * 256 * 2,
                 OW_LRU = OW_OUT + (size_t)D * D * 2, OW_GLU = OW_LRU + (size_t)512 * 256 * 2, OW_Q = OW_GLU + (size_t)256 * 256 * 2, OW_KV = OW_Q + (size_t)D * D * 2,
                 OW_O = OW_KV + (size_t)2048 * D * 2, OW_GU = OW_O + (size_t)D * D * 2, OW_DOWN = OW_GU + (size_t)2 * FF * D * 2, OW_END = OW_DOWN + (size_t)D * FF * 2;
constexpr size_t WL_STRIDE = 43 * MiB;
static_assert(OW_END <= WL_STRIDE, "weights");
constexpr size_t WS_W = 0;
constexpr size_t WS_SMALL = 88 * MiB;
constexpr size_t SM_COS = WS_SMALL, SM_SIN = SM_COS + MiB, SM_S5P = SM_SIN + MiB, SM_BB = SM_S5P + 64 * 1024, SM_CM = SM_BB + 256 * 1024,
                 SM_MN = SM_CM + 128 * 1024, SM_KM = SM_MN + 8 * MiB, SM_VT = SM_KM + 4 * MiB, SM_SLOC = SM_VT + 4 * MiB, SM_DTOT = SM_SLOC + 16 * MiB,
                 SM_S5L = SM_DTOT + 256 * 1024, SM_LL = SM_S5L + MiB, SM_LB = SM_LL + MiB, SM_END = SM_LB + 4096;
static_assert(SM_END <= 128 * MiB, "small");
constexpr size_t WS_H = 128 * MiB, WS_Z = 256 * MiB, WS_Q = 608 * MiB, WS_X = 736 * MiB, WS_P = 768 * MiB, WS_END = 896 * MiB;
constexpr size_t WS_CTL = 126 * MiB, WS_XB = WS_END;
static_assert(SM_END <= WS_CTL, "ctl");
constexpr size_t WS_LG = WS_Q, WS_ACT5 = WS_Q + 64 * MiB;

constexpr int LDS_BYTES = 140 * 1024;
constexpr int GL_QD = 0, GL_KI = 4608, GL_KT = 9216, GL_VT = 14336, GL_ST = 19456, GL_BE = 28672, GL_BYTES = 28928;
constexpr int S5_OFF = 4 * GL_BYTES, S5_BYTES = 1024 + 4352;
static_assert(S5_OFF + 4 * S5_BYTES <= LDS_BYTES, "lds");

__device__ __forceinline__ float bf2f(unsigned b) { return __uint_as_float(b << 16); }
__device__ __forceinline__ float bflo(unsigned w) { return __uint_as_float(w << 16); }
__device__ __forceinline__ float bfhi(unsigned w) { return __uint_as_float(w & 0xffff0000u); }
__device__ __forceinline__ unsigned pk2(float lo, float hi) { unsigned r; asm("s_nop 1\n\tv_cvt_pk_bf16_f32 %0, %1, %2" : "=v"(r) : "v"(lo), "v"(hi)); return r; }
__device__ __forceinline__ bf16_t f2bf(float f) { return (bf16_t)(pk2(f, 0.f) & 0xffffu); }
__device__ __forceinline__ float sigm(float x) { return __builtin_amdgcn_rcpf(1.f + __expf(-x)); }
__device__ __forceinline__ float siluf(float x) { return x * sigm(x); }
__device__ __forceinline__ float gelu_t(float x) { const float u = 0.7978845608028654f * (x + 0.044715f * x * x * x); const float th = 1.f - 2.f * __builtin_amdgcn_rcpf(1.f + __expf(2.f * u)); return 0.5f * x * (1.f + th); }
__device__ __forceinline__ float wave_sum(float v) {
#pragma unroll
    for (int o = 1; o < 64; o <<= 1) v += __shfl_xor(v, o);
    return v;
}
__device__ __forceinline__ float wave_max(float v) {
#pragma unroll
    for (int o = 1; o < 64; o <<= 1) v = fmaxf(v, __shfl_xor(v, o));
    return v;
}
#define ENC(md) (100.f * (floorf(log2f(fmaxf((md), 1e-9f))) + 40.f))
#define LDS_FENCE() asm volatile("s_waitcnt lgkmcnt(0)" ::: "memory")
__device__ __forceinline__ void sincos_acc(double x, float& s, float& c) {
    const double q = rint(x * 0.63661977236758134308);
    double r = fma(-q, 1.57079632679489655800, x); r = fma(-q, 6.12323399573676603587e-17, r);
    const double r2 = r * r;
    double sp = -1.0 / 1307674368000.0; sp = sp * r2 + 1.0 / 6227020800.0; sp = sp * r2 - 1.0 / 39916800.0; sp = sp * r2 + 1.0 / 362880.0; sp = sp * r2 - 1.0 / 5040.0; sp = sp * r2 + 1.0 / 120.0; sp = sp * r2 - 1.0 / 6.0; sp = sp * r2 * r + r;
    double cp = 1.0 / 20922789888000.0; cp = cp * r2 - 1.0 / 87178291200.0; cp = cp * r2 + 1.0 / 479001600.0; cp = cp * r2 - 1.0 / 3628800.0; cp = cp * r2 + 1.0 / 40320.0; cp = cp * r2 - 1.0 / 720.0; cp = cp * r2 + 1.0 / 24.0; cp = cp * r2 - 0.5; cp = cp * r2 + 1.0;
    const int qi = ((int)(long long)q) & 3;
    const double ss = (qi & 1) ? cp : sp, cc = (qi & 1) ? sp : cp;
    s = (float)((qi & 2) ? -ss : ss); c = (float)(((qi + 1) & 2) ? -cc : cc);
}

namespace pg8 {
constexpr int BM = 256, BK = 64, HALF = 128, HTB = HALF * BK * 2, STAGE_BYTES = 8 * HTB, NXCD = 8, WGM = 8;
__host__ __device__ __forceinline__ int lds_byte(int r, int c) { const int st = (r >> 4) * 2 + (c >> 5), rr = r & 15, cc = c & 31, ob = rr * 64 + cc * 2; return st * 1024 + (ob ^ (((ob >> 9) & 1) << 5)); }
__host__ __device__ __forceinline__ void stage_rc(int b, int& R, int& C) { const int st = b / 1024, sb = b % 1024, swz = sb ^ (((sb >> 9) & 1) << 5); R = (st >> 1) * 16 + swz / 64; C = (st & 1) * 32 + (swz % 64) / 2; }
__host__ __device__ __forceinline__ int perm32(int rho) { const int n = rho >> 4, i = rho & 15; return 8 * (i >> 2) + 4 * n + (i & 3); }
struct Unit { int pm, pn; };
template <int M_, int N_, int K_, int LDA_, int LDB_, int APD_ = 1, int APM_ = 0, long BPS_ = -1, int BPD_ = 1, long BPM_ = 0>
struct GS { static constexpr int M = M_, N = N_, K = K_, lda = LDA_, ldb = LDB_, a_pn_div = APD_, a_pn_mul = APM_, b_pm_div = BPD_; static constexpr long b_pn_stride = BPS_ < 0 ? 256L * LDB_ : BPS_, b_pm_mul = BPM_; };
constexpr int GRID = 256;
template <class G_> struct StaticOrder {
    static constexpr int nM = G_::M / BM, nN = G_::N / BM, nwg = nM * nN, G = GRID;
    int c;
    __device__ __forceinline__ bool next(int i, Unit& u) const {
        const int L = i * G + c; if (L >= nwg) return false;
        int wgid = L; { constexpr int q = nwg / NXCD, r = nwg % NXCD; const int xcd = wgid % NXCD, off = wgid / NXCD; wgid = (xcd < r ? xcd * (q + 1) : r * (q + 1) + (xcd - r) * q) + off; }
        constexpr int nig = WGM * nN; const int gid = wgid / nig, fm = gid * WGM, gsz = (nM - fm) < WGM ? (nM - fm) : WGM;
        u.pm = fm + ((wgid % nig) % gsz); u.pn = (wgid % nig) / gsz; return true;
    }
};

template <int MODE  , int ldc, int ldm = 0> struct EpiBf16 {
    static constexpr bool PERM = true;
    bf16_t* O; const float* bias; const bf16_t* mul;
    __device__ __forceinline__ void operator()(const f32x4 (&acc)[2][2][4][2], const Unit& u, int wr, int wc, int fr, int fq) const {
        const int row0 = u.pm * BM + wr * 64 + fr, col0 = u.pn * BM + wc * 32 + 8 * fq;
        f32x4 bv[2][2];
#pragma unroll
        for (int bj = 0; bj < 2; ++bj)
#pragma unroll
            for (int n = 0; n < 2; ++n) bv[bj][n] = (MODE == 1 || MODE == 2) ? *(const f32x4*)(bias + col0 + bj * HALF + 4 * n) : (f32x4){0.f, 0.f, 0.f, 0.f};
#pragma unroll
        for (int ai = 0; ai < 2; ++ai)
#pragma unroll
            for (int m = 0; m < 4; ++m) {
                const size_t row = (size_t)(row0 + ai * HALF + m * 16);
                bf16_t* rowp = O + row * ldc + col0;
#pragma unroll
                for (int bj = 0; bj < 2; ++bj) {
                    f32x4 v0 = acc[ai][bj][m][0], v1 = acc[ai][bj][m][1];
                    if (MODE == 3) { v0 = v0 * 0.0625f; v1 = v1 * 0.0625f; }
                    else if (MODE != 0) {
                        v0 = v0 + bv[bj][0]; v1 = v1 + bv[bj][1];
#pragma unroll
                        for (int j = 0; j < 4; ++j) { v0[j] = sigm(v0[j]); v1[j] = sigm(v1[j]); }
                        if (MODE == 2) { const u32x4 mw = *(const u32x4*)(mul + row * ldm + col0 + bj * HALF);
                            v0[0] *= bflo(mw.x); v0[1] *= bfhi(mw.x); v0[2] *= bflo(mw.y); v0[3] *= bfhi(mw.y); v1[0] *= bflo(mw.z); v1[1] *= bfhi(mw.z); v1[2] *= bflo(mw.w); v1[3] *= bfhi(mw.w); }
                    }
                    u32x4 w; w.x = pk2(v0[0], v0[1]); w.y = pk2(v0[2], v0[3]); w.z = pk2(v1[0], v1[1]); w.w = pk2(v1[2], v1[3]);
                    *(u32x4*)(rowp + bj * HALF) = w;
                }
            }
    }
};
template <int ldc> struct EpiF32 {
    static constexpr bool PERM = false;
    float* C; float scale;
    __device__ __forceinline__ void operator()(const f32x4 (&acc)[2][2][4][2], const Unit& u, int wr, int wc, int fr, int fq) const {
        const int row0 = u.pm * BM + wr * 64 + fr, col0 = u.pn * BM + wc * 32 + 4 * fq;
#pragma unroll
        for (int ai = 0; ai < 2; ++ai)
#pragma unroll
            for (int m = 0; m < 4; ++m) { float* rowp = C + (size_t)(row0 + ai * HALF + m * 16) * ldc + col0;
#pragma unroll
                for (int bj = 0; bj < 2; ++bj)
#pragma unroll
                    for (int n = 0; n < 2; ++n) *(f32x4*)(rowp + bj * HALF + n * 16) = acc[ai][bj][m][n] * scale; }
    }
};
struct EpiMix {
    static constexpr bool PERM = false;
    bf16_t* O; const float* bias; const bf16_t* up;
    __device__ __forceinline__ void operator()(const f32x4 (&acc)[2][2][4][2], const Unit& u, int wr, int wc, int fr, int fq) const {
        const int row0 = u.pm * BM + wr * 64 + fr, c0 = u.pn * 64 + wc * 16 + 4 * fq;
        f32x4 bv[2][2];
#pragma unroll
        for (int bj = 0; bj < 2; ++bj)
#pragma unroll
            for (int n = 0; n < 2; ++n) bv[bj][n] = *(const f32x4*)(bias + (2 * bj + n) * 1024 + c0);
#pragma unroll
        for (int ai = 0; ai < 2; ++ai)
#pragma unroll
            for (int m = 0; m < 4; ++m) {
                const size_t row = (size_t)(row0 + ai * HALF + m * 16);
                f32x4 s = (f32x4){0.f, 0.f, 0.f, 0.f};
#pragma unroll
                for (int bj = 0; bj < 2; ++bj)
#pragma unroll
                    for (int n = 0; n < 2; ++n) {
                        const u32x2 uw = *(const u32x2*)(up + row * 4096 + (2 * bj + n) * 1024 + c0);
                        const f32x4 g = acc[ai][bj][m][n] + bv[bj][n];
                        s[0] += sigm(g[0]) * bflo(uw.x); s[1] += sigm(g[1]) * bfhi(uw.x); s[2] += sigm(g[2]) * bflo(uw.y); s[3] += sigm(g[3]) * bfhi(uw.y);
                    }
                u32x2 w; w.x = pk2(s[0], s[1]); w.y = pk2(s[2], s[3]);
                *(u32x2*)(O + row * 1024 + c0) = w;
            }
    }
};
struct EpiGU {
    static constexpr bool PERM = false;
    bf16_t* O;
    __device__ __forceinline__ void operator()(const f32x4 (&acc)[2][2][4][2], const Unit& u, int wr, int wc, int fr, int fq) const {
        const int row0 = u.pm * BM + wr * 64 + fr, c0 = u.pn * 128 + wc * 16 + 4 * fq;
#pragma unroll
        for (int ai = 0; ai < 2; ++ai)
#pragma unroll
            for (int m = 0; m < 4; ++m) {
                const size_t row = (size_t)(row0 + ai * HALF + m * 16);
#pragma unroll
                for (int bj = 0; bj < 2; ++bj) {
                    const f32x4 g = acc[ai][bj][m][0], p = acc[ai][bj][m][1];
                    u32x2 w; w.x = pk2(siluf(g[0]) * p[0], siluf(g[1]) * p[1]); w.y = pk2(siluf(g[2]) * p[2], siluf(g[3]) * p[3]);
                    *(u32x2*)(O + row * FF + c0 + 64 * bj) = w;
                }
            }
    }
};

template <class g, class Epi>
__device__ __forceinline__ void gemm_phase(int tid, LAS unsigned char* lds, const bf16_t* gA, const bf16_t* gBt, int cblk, const Epi& E) {
    StaticOrder<g> S; S.c = cblk;
    const int wid = __builtin_amdgcn_readfirstlane(tid >> 6), lane = tid & 63, wr = wid >> 2, wc = wid & 3, fr = lane & 15, fq = lane >> 4;
    constexpr int K = g::K, nt = K / BK;
    unsigned voffA[2], voffB[2];
#pragma unroll
    for (int i = 0; i < 2; ++i) { int R, C; stage_rc(tid * 16 + i * 8192, R, C); const int Rb = Epi::PERM ? ((R & ~31) + perm32(R & 31)) : R;
        voffA[i] = (unsigned)(R * g::lda + C) * 2u; voffB[i] = (unsigned)(Rb * g::ldb + C) * 2u; }
    constexpr size_t kstep = (size_t)(BK * 2);
    constexpr size_t hstepA = (size_t)HALF * g::lda * 2, hstepB = (size_t)HALF * g::ldb * 2;
    const unsigned ldsw = (unsigned)wid * 1024u;
    const int aoff = lds_byte(wr * 64 + fr, fq * 8), boff = lds_byte(wc * 32 + fr, fq * 8);
#define PG8_SA(b, h) (((b) * 2 + (h)) * HTB)
#define PG8_SB(b, h) ((4 + (b) * 2 + (h)) * HTB)
#define PG8_STAGE(bufoff, gbase, voff) do { _Pragma("unroll") for (int _i = 0; _i < 2; ++_i) \
        __builtin_amdgcn_global_load_lds((const unsigned*)((const char*)(gbase) + (voff)[_i]), (LAS unsigned*)(lds + (bufoff) + ldsw + _i * 8192), 16, 0, 0); } while (0)
#define PG8_LDA(dst, b, h) do { _Pragma("unroll") for (int m = 0; m < 4; ++m) _Pragma("unroll") for (int k = 0; k < 2; ++k) dst[m][k] = *(const LAS bf16x8*)(lds + PG8_SA(b, h) + aoff + m * 2048 + k * 1024); } while (0)
#define PG8_LDB(dst, b, h) do { _Pragma("unroll") for (int n = 0; n < 2; ++n) _Pragma("unroll") for (int k = 0; k < 2; ++k) dst[n][k] = *(const LAS bf16x8*)(lds + PG8_SB(b, h) + boff + n * 2048 + k * 1024); } while (0)
#define PG8_MMA(ai, bj, At, Bt) do { __builtin_amdgcn_s_setprio(1); _Pragma("unroll") for (int m = 0; m < 4; ++m) _Pragma("unroll") for (int n = 0; n < 2; ++n) _Pragma("unroll") for (int k = 0; k < 2; ++k) \
        acc[ai][bj][m][n] = __builtin_amdgcn_mfma_f32_16x16x32_bf16(Bt[n][k], At[m][k], acc[ai][bj][m][n], 0, 0, 0); __builtin_amdgcn_s_setprio(0); } while (0)
#define PG8_WAIT_V(n) asm volatile("s_waitcnt vmcnt(" #n ")" ::: "memory")
#define PG8_WAIT_L(n) asm volatile("s_waitcnt lgkmcnt(" #n ")" ::: "memory")
#define PG8_BAR __builtin_amdgcn_s_barrier()
#define PG8_SCHED __builtin_amdgcn_sched_barrier(0)
#define PG8_ABASE(u) ((const char*)gA + ((size_t)(u).pm * BM * g::lda + (size_t)((u).pn / g::a_pn_div) * g::a_pn_mul) * 2)
#define PG8_BBASE(u) ((const char*)gBt + ((size_t)(u).pn * g::b_pn_stride + (size_t)((u).pm / g::b_pm_div) * g::b_pm_mul) * 2)
    Unit cur, nxt; int ui = 0;
    if (!S.next(0, cur)) return;
    f32x4 acc[2][2][4][2];
#pragma unroll
    for (int a = 0; a < 2; ++a)
#pragma unroll
        for (int b = 0; b < 2; ++b)
#pragma unroll
            for (int m = 0; m < 4; ++m)
#pragma unroll
                for (int n = 0; n < 2; ++n) acc[a][b][m][n] = (f32x4){0.f, 0.f, 0.f, 0.f};
    bf16x8 At[4][2], B0[2][2], B1[2][2];
    const char* cA = PG8_ABASE(cur); const char* cB = PG8_BBASE(cur);
    PG8_STAGE(PG8_SB(0, 0), cB, voffB); PG8_STAGE(PG8_SA(0, 0), cA, voffA); PG8_STAGE(PG8_SB(0, 1), cB + hstepB, voffB); PG8_STAGE(PG8_SA(0, 1), cA + hstepA, voffA);
    if (wr == 1) PG8_BAR;
    PG8_WAIT_V(4); PG8_BAR;
    PG8_STAGE(PG8_SB(1, 0), cB + kstep, voffB); PG8_STAGE(PG8_SA(1, 0), cA + kstep, voffA); PG8_STAGE(PG8_SB(1, 1), cB + hstepB + kstep, voffB);
    PG8_WAIT_V(6); PG8_BAR;
    for (;;) {
        const bool has_next = S.next(ui + 1, nxt);
        const char* nA = has_next ? PG8_ABASE(nxt) : cA; const char* nB = has_next ? PG8_BBASE(nxt) : cB;
#pragma unroll 1
        for (int t = 0; t < nt; t += 2) {
            const bool last = (t == nt - 2);
            const char* a1 = cA + (size_t)(t + 1) * kstep;
            const char* a2 = last ? nA : cA + (size_t)(t + 2) * kstep; const char* b2 = last ? nB : cB + (size_t)(t + 2) * kstep;
            const char* a3 = a2 + kstep; const char* b3 = b2 + kstep;
            PG8_LDB(B0, 0, 0); PG8_SCHED; PG8_LDA(At, 0, 0); PG8_STAGE(PG8_SA(1, 1), a1 + hstepA, voffA);
            PG8_WAIT_L(8); PG8_BAR; PG8_WAIT_L(0); PG8_MMA(0, 0, At, B0); PG8_BAR; PG8_SCHED;
            PG8_LDB(B1, 0, 1); PG8_STAGE(PG8_SB(0, 0), b2, voffB);
            PG8_BAR; PG8_WAIT_L(0); PG8_MMA(0, 1, At, B1); PG8_BAR;
            PG8_LDA(At, 0, 1); PG8_STAGE(PG8_SA(0, 0), a2, voffA);
            PG8_BAR; PG8_WAIT_L(0); PG8_MMA(1, 0, At, B0); PG8_BAR; PG8_SCHED;
            PG8_STAGE(PG8_SB(0, 1), b2 + hstepB, voffB);
            PG8_WAIT_V(6); PG8_BAR; PG8_MMA(1, 1, At, B1); PG8_BAR;
            PG8_LDB(B0, 1, 0); PG8_SCHED; PG8_LDA(At, 1, 0); PG8_STAGE(PG8_SA(0, 1), a2 + hstepA, voffA);
            PG8_WAIT_L(8); PG8_BAR; PG8_WAIT_L(0); PG8_MMA(0, 0, At, B0); PG8_BAR; PG8_SCHED;
            PG8_LDB(B1, 1, 1); PG8_STAGE(PG8_SB(1, 0), b3, voffB);
            PG8_BAR; PG8_WAIT_L(0); PG8_MMA(0, 1, At, B1); PG8_BAR;
            PG8_LDA(At, 1, 1); PG8_STAGE(PG8_SA(1, 0), a3, voffA);
            PG8_BAR; PG8_WAIT_L(0); PG8_MMA(1, 0, At, B0); PG8_BAR; PG8_SCHED;
            PG8_STAGE(PG8_SB(1, 1), b3 + hstepB, voffB);
            PG8_WAIT_V(6); PG8_BAR; PG8_MMA(1, 1, At, B1); PG8_BAR;
        }
        E(acc, cur, wr, wc, fr, fq);
        if (!has_next) break;
#pragma unroll
        for (int a = 0; a < 2; ++a)
#pragma unroll
            for (int b = 0; b < 2; ++b)
#pragma unroll
                for (int m = 0; m < 4; ++m)
#pragma unroll
                    for (int n = 0; n < 2; ++n) acc[a][b][m][n] = (f32x4){0.f, 0.f, 0.f, 0.f};
        cur = nxt; cA = nA; cB = nB; ++ui;
    }
    PG8_WAIT_V(0);
    if (wr == 0) PG8_BAR;
    PG8_BAR;
#undef PG8_SA
#undef PG8_SB
#undef PG8_STAGE
#undef PG8_LDA
#undef PG8_LDB
#undef PG8_MMA
#undef PG8_WAIT_V
#undef PG8_WAIT_L
#undef PG8_BAR
#undef PG8_SCHED
#undef PG8_ABASE
#undef PG8_BBASE
}
}

struct Args { const float* in[39]; float* out; unsigned char* ws; int ph_lo, ph_hi; };
enum { I_X = 0, I_MEM, I_HGLB, I_NMIXPRE, I_NMIXPOST, I_WIN, I_WGATE, I_BGATE, I_HGNORM, I_RETNORM, I_CONVW, I_CONVB, I_WA, I_BA, I_WX, I_BX, I_LAM,
       I_S5LRE, I_S5LIM, I_S5BRE, I_S5BIM, I_S5CRE, I_S5CIM, I_S5D, I_S5LDT, I_GLUW, I_GLUB, I_WUP, I_WOUT, I_NXAPRE, I_NXAPOST, I_NMEM, I_WQ, I_WKV, I_WO,
       I_NFFNPRE, I_NFFNPOST, I_WGU, I_WDOWN };

struct Ctx {
    LAS const unsigned long long* pt; unsigned char* ws;
    __device__ __forceinline__ const float* in(int k) const { const unsigned long long v = pt[k]; const unsigned lo = __builtin_amdgcn_readfirstlane((unsigned)v), hi = __builtin_amdgcn_readfirstlane((unsigned)(v >> 32)); return (const float*)(((unsigned long long)hi << 32) | lo); }
};
__device__ __forceinline__ int src_col(int mode, int n) {
    if (mode == 0) return n;
    const int pn = n >> 8, L = n & 255, bj = L >> 7, wc = (L >> 5) & 3, nn = (L >> 4) & 1, r = L & 15;
    if (mode == 1) return (2 * bj + nn) * 1024 + 64 * pn + 16 * wc + r;
    const int ff = 128 * pn + 64 * bj + 16 * wc + r; return nn ? FF + ff : ff;
}
__device__ __forceinline__ void transpose_item(const float* W, int ldw, int K, int N, bf16_t* WT, int mode, LAS float* scr, int it, int lane) {
    const int nblk = N / 32;
    const int kb = it / nblk, nb = it % nblk, k0 = 64 * kb, n0 = 32 * nb;
    const int sc = src_col(mode, n0 + (lane & 31));
#pragma unroll 8
    for (int i = 0; i < 32; ++i) { const int kk = 2 * i + (lane >> 5); scr[kk * 33 + (lane & 31)] = W[(size_t)(k0 + kk) * ldw + sc]; }
    LDS_FENCE();
    const int c = lane & 7;
#pragma unroll
    for (int j = 0; j < 4; ++j) { const int n = (lane >> 3) + 8 * j; const LAS float* s = scr + (8 * c) * 33 + n;
        u32x4 o; o.x = pk2(s[0 * 33], s[1 * 33]); o.y = pk2(s[2 * 33], s[3 * 33]); o.z = pk2(s[4 * 33], s[5 * 33]); o.w = pk2(s[6 * 33], s[7 * 33]);
        *(u32x4*)(WT + (size_t)(n0 + n) * K + k0 + 8 * c) = o; }
    LDS_FENCE();
}
template <bool SRC16, bool DST16>
__device__ __forceinline__ void addnorm_rows(const void* xsrc_, void* xdst_, const bf16_t* y, const float* gpost, const float* gpre, bf16_t* h, int nrows, int gw, int NGW, int lane) {
    for (int row0 = gw; row0 < nrows; row0 += 2 * NGW) {
        const int nr = (row0 + NGW < nrows) ? 2 : 1;
        f32x4 v[2][4]; u32x2 yw[2][4];
#pragma unroll
        for (int u = 0; u < 2; ++u) if (u < nr) { const size_t row = (size_t)(row0 + u * NGW);
            if (SRC16) { const u32x2* xr = (const u32x2*)((const bf16_t*)xsrc_ + row * D) + lane;
#pragma unroll
                for (int j = 0; j < 4; ++j) { const u32x2 w = xr[64 * j]; v[u][j] = (f32x4){bflo(w.x), bfhi(w.x), bflo(w.y), bfhi(w.y)}; } }
            else { const f32x4* xr = (const f32x4*)((const float*)xsrc_ + row * D) + lane;
#pragma unroll
                for (int j = 0; j < 4; ++j) v[u][j] = xr[64 * j]; }
            if (y) { const u32x2* yr = (const u32x2*)(y + row * D) + lane;
#pragma unroll
                for (int j = 0; j < 4; ++j) yw[u][j] = yr[64 * j]; } }
#pragma unroll
        for (int u = 0; u < 2; ++u) if (u < nr) { const size_t row = (size_t)(row0 + u * NGW);
            if (y) {
                f32x4 yv[4]; float ss = 0.f;
#pragma unroll
                for (int j = 0; j < 4; ++j) { const u32x2 w = yw[u][j]; yv[j] = (f32x4){bflo(w.x), bfhi(w.x), bflo(w.y), bfhi(w.y)}; ss += yv[j][0] * yv[j][0] + yv[j][1] * yv[j][1] + yv[j][2] * yv[j][2] + yv[j][3] * yv[j][3]; }
                ss = wave_sum(ss); const float rs = rsqrtf(ss * (1.f / D) + EPS);
#pragma unroll
                for (int j = 0; j < 4; ++j) { const f32x4 g = ((const f32x4*)gpost)[64 * j + lane]; v[u][j] = v[u][j] + yv[j] * rs * g; }
            }
            if (xdst_) {
                if (DST16) { u32x2* xw = (u32x2*)((bf16_t*)xdst_ + row * D) + lane;
#pragma unroll
                    for (int j = 0; j < 4; ++j) { u32x2 w; w.x = pk2(v[u][j][0], v[u][j][1]); w.y = pk2(v[u][j][2], v[u][j][3]); xw[64 * j] = w; } }
                else { f32x4* xw = (f32x4*)((float*)xdst_ + row * D) + lane;
#pragma unroll
                    for (int j = 0; j < 4; ++j) xw[64 * j] = v[u][j]; } }
            if (h) {
                float ss = 0.f;
#pragma unroll
                for (int j = 0; j < 4; ++j) ss += v[u][j][0] * v[u][j][0] + v[u][j][1] * v[u][j][1] + v[u][j][2] * v[u][j][2] + v[u][j][3] * v[u][j][3];
                ss = wave_sum(ss); const float rs = rsqrtf(ss * (1.f / D) + EPS);
                u32x2* hw = (u32x2*)(h + row * D) + lane;
#pragma unroll
                for (int j = 0; j < 4; ++j) { const f32x4 g = ((const f32x4*)gpre)[64 * j + lane]; const f32x4 o = v[u][j] * rs * g; u32x2 w; w.x = pk2(o[0], o[1]); w.y = pk2(o[2], o[3]); hw[64 * j] = w; }
            } }
    }
}

template <bool OUT>
__device__ __forceinline__ void gla_item(const Ctx& a, int layer, int item, LAS unsigned char* wl, int lane) {
    unsigned char* ws = a.ws;
    const int hh = item & 3, mx = (item >> 2) & 1, sc = (item >> 3) & 15, b = item >> 7;
    const int r = lane & 31, h = lane >> 5;
    const bf16_t* Z = (const bf16_t*)(ws + WS_Z);
    bf16_t* YC = (bf16_t*)(ws + WS_P);
    float* SLOC = (float*)(ws + SM_SLOC); float* DTOT = (float*)(ws + SM_DTOT);
    const float* COS = (const float*)(ws + SM_COS); const float* SIN = (const float*)(ws + SM_SIN);
    LAS bf16_t* QD = (LAS bf16_t*)(wl + GL_QD); LAS bf16_t* KI = (LAS bf16_t*)(wl + GL_KI); LAS bf16_t* KT = (LAS bf16_t*)(wl + GL_KT);
    LAS bf16_t* VT = (LAS bf16_t*)(wl + GL_VT); LAS bf16_t* ST = (LAS bf16_t*)(wl + GL_ST); LAS float* BE = (LAS float*)(wl + GL_BE);
    LAS bf16_t* PM = KI;
    const int cq = (mx ? 1024 : 0) + 64 * hh + lane;
    float lb = 0.f, lgam = 0.f;
    if (mx == 0) { if (layer > 0) { const float b0 = a.in(I_HGLB)[64 * hh + lane], b1 = a.in(I_HGLB)[256 + 64 * hh + lane]; const float mxb = fmaxf(b0, b1); const float e0 = __expf(b0 - mxb), e1 = __expf(b1 - mxb); lb = e1 / (e0 + e1); } }
    else lgam = log1pf(-exp2f(-5.f - (float)hh));
    f32x16 S[2][2];
#pragma unroll
    for (int mt = 0; mt < 2; ++mt)
#pragma unroll
        for (int nt = 0; nt < 2; ++nt)
#pragma unroll
            for (int e = 0; e < 16; ++e) S[mt][nt][e] = 0.f;
    if (OUT) {
        { const float* sl = SLOC + (size_t)item * 4096 + (4 * h) * 64 + r;
#pragma unroll
          for (int mt = 0; mt < 2; ++mt)
#pragma unroll
              for (int nt = 0; nt < 2; ++nt)
#pragma unroll
                  for (int e = 0; e < 16; ++e) S[mt][nt][e] = sl[(32 * mt + (e & 3) + 8 * (e >> 2)) * 64 + 32 * nt]; }
#pragma unroll
        for (int mt = 0; mt < 2; ++mt)
#pragma unroll
            for (int nt = 0; nt < 2; ++nt)
#pragma unroll
                for (int g4 = 0; g4 < 4; ++g4) { u32x2 w; w.x = pk2(S[mt][nt][4 * g4], S[mt][nt][4 * g4 + 1]); w.y = pk2(S[mt][nt][4 * g4 + 2], S[mt][nt][4 * g4 + 3]);
                    *(LAS u32x2*)(ST + (32 * nt + r) * 72 + 32 * mt + 8 * g4 + 4 * h) = w; }
    }
    float btot = 0.f;
    const size_t tok0 = (size_t)b * SEQ + (size_t)sc * 512;
    const float* gn = a.in(mx ? I_RETNORM : I_HGNORM) + layer * 256 + 64 * hh;
    const int cq0 = (mx ? 1024 : 0) + 64 * hh;
    LAS bf16_t* VS = KT;
    const int ptok = lane >> 3, pc8 = (lane & 7) * 8;
    u32x4 pq[4], pf[4], pv[4]; float pc0 = 1.f, ps0 = 0.f, cd = 1.f, sd = 0.f;
    if (mx) { cd = COS[32 + (lane >> 1)]; sd = SIN[32 + (lane >> 1)]; }
#define GLA_PREFETCH(chn) do { const bf16_t* zp = Z + (tok0 + (size_t)(chn) * 32 + ptok) * INC + cq0 + pc8; \
        _Pragma("unroll") for (int i = 0; i < 4; ++i) { const bf16_t* zz = zp + (size_t)(8 * i) * INC; if (OUT) pq[i] = *(const u32x4*)zz; pf[i] = *(const u32x4*)(zz + 256); pv[i] = *(const u32x4*)(zz + 512); } \
        if (mx) { pc0 = COS[(sc * 512 + (chn) * 32) * 32 + (lane >> 1)]; ps0 = SIN[(sc * 512 + (chn) * 32) * 32 + (lane >> 1)]; } } while (0)
    GLA_PREFETCH(0);
#pragma unroll 1
    for (int ch = 0; ch < 16; ++ch) {
        const bf16_t* zr = Z + (tok0 + ch * 32) * INC;
#pragma unroll
        for (int i = 0; i < 4; ++i) { const int tk = ptok + 8 * i; if (OUT) *(LAS u32x4*)(QD + tk * 72 + pc8) = pq[i]; *(LAS u32x4*)(KI + tk * 72 + pc8) = pf[i]; *(LAS u32x4*)(VS + tk * 64 + pc8) = pv[i]; }
        float cs = pc0, sn = ps0;
        LDS_FENCE();
        if (ch + 1 < 16) GLA_PREFETCH(ch + 1);
        u32x2 gpre[2][4];
        if (OUT) { const bf16_t* zt = zr + (size_t)r * INC + cq0 + 768;
#pragma unroll
            for (int mt = 0; mt < 2; ++mt)
#pragma unroll
                for (int g4 = 0; g4 < 4; ++g4) gpre[mt][g4] = *(const u32x2*)(zt + 32 * mt + 8 * g4 + 4 * h); }
#pragma unroll
        for (int t4 = 0; t4 < 32; t4 += 4) { u32x2 w; w.x = (unsigned)VS[t4 * 64 + lane] | ((unsigned)VS[(t4 + 1) * 64 + lane] << 16); w.y = (unsigned)VS[(t4 + 2) * 64 + lane] | ((unsigned)VS[(t4 + 3) * 64 + lane] << 16);
            *(LAS u32x2*)(VT + lane * 40 + t4) = w; }
        LDS_FENCE();
        float bc = 0.f;
#pragma unroll 2
        for (int t4 = 0; t4 < 32; t4 += 4) {
            float kiv[4];
#pragma unroll
            for (int u = 0; u < 4; ++u) {
                const int t = t4 + u;
                float qv = OUT ? bf2f(QD[t * 72 + lane]) : 0.f; float fv = bf2f(KI[t * 72 + lane]);
                float kk, lf;
                if (mx == 0) { const float f = lb + (1.f - lb) * sigm(fv); lf = __logf(f); kk = 1.f - f; qv = siluf(qv); }
                else {
                    const float qp = __shfl_xor(qv, 1), kp = __shfl_xor(fv, 1);
                    const float sg = (lane & 1) ? sn : -sn;
                    qv = qv * cs + qp * sg; kk = (fv * cs + kp * sg) * 0.125f; lf = lgam;
                    const float c2 = cs * cd - sn * sd; sn = sn * cd + cs * sd; cs = c2;
                }
                bc += lf;
                const float e = __expf(bc), ei = __expf(-bc);
                if (OUT) QD[t * 72 + lane] = f2bf(qv * e);
                const float ki = kk * ei;
                KI[t * 72 + lane] = f2bf(ki); kiv[u] = ki;
            }
            u32x2 w; w.x = pk2(kiv[0], kiv[1]); w.y = pk2(kiv[2], kiv[3]); *(LAS u32x2*)(KT + lane * 40 + t4) = w;
        }
        BE[lane] = bc; btot += bc;
        LDS_FENCE();
        if (OUT) {
            f32x16 sct;
#pragma unroll
            for (int e = 0; e < 16; ++e) sct[e] = 0.f;
#pragma unroll
            for (int ks = 0; ks < 4; ++ks) { const bf16x8 av = *(const LAS bf16x8*)(KI + r * 72 + 16 * ks + 8 * h), bq = *(const LAS bf16x8*)(QD + r * 72 + 16 * ks + 8 * h);
                sct = __builtin_amdgcn_mfma_f32_32x32x16_bf16(av, bq, sct, 0, 0, 0); }
            LDS_FENCE();
#pragma unroll
            for (int g4 = 0; g4 < 4; ++g4) { const int s0 = 8 * g4 + 4 * h; float p[4];
#pragma unroll
                for (int i = 0; i < 4; ++i) p[i] = (s0 + i <= r) ? sct[4 * g4 + i] : 0.f;
                u32x2 w; w.x = pk2(p[0], p[1]); w.y = pk2(p[2], p[3]); *(LAS u32x2*)(PM + r * 40 + s0) = w; }
            LDS_FENCE();
            f32x16 oT[2];
#pragma unroll
            for (int mt = 0; mt < 2; ++mt) {
                __builtin_amdgcn_sched_barrier(0);
#pragma unroll
                for (int e = 0; e < 16; ++e) oT[mt][e] = 0.f;
#pragma unroll
                for (int ks = 0; ks < 2; ++ks) { const bf16x8 av = *(const LAS bf16x8*)(VT + (32 * mt + r) * 40 + 16 * ks + 8 * h), bp = *(const LAS bf16x8*)(PM + r * 40 + 16 * ks + 8 * h);
                    oT[mt] = __builtin_amdgcn_mfma_f32_32x32x16_bf16(av, bp, oT[mt], 0, 0, 0); }
#pragma unroll
                for (int ks = 0; ks < 4; ++ks) { const bf16x8 av = *(const LAS bf16x8*)(ST + (32 * mt + r) * 72 + 16 * ks + 8 * h), bq = *(const LAS bf16x8*)(QD + r * 72 + 16 * ks + 8 * h);
                    oT[mt] = __builtin_amdgcn_mfma_f32_32x32x16_bf16(av, bq, oT[mt], 0, 0, 0); }
            }
            __builtin_amdgcn_sched_barrier(0);
            float ss = 0.f;
#pragma unroll
            for (int mt = 0; mt < 2; ++mt)
#pragma unroll
                for (int e = 0; e < 16; ++e) ss += oT[mt][e] * oT[mt][e];
            ss += __shfl_xor(ss, 32);
            const float rs = rsqrtf(ss * (1.f / 64.f) + EPS);
            bf16_t* yo = YC + (tok0 + ch * 32 + r) * D + 256 * mx + 64 * hh;
#pragma unroll
            for (int mt = 0; mt < 2; ++mt)
#pragma unroll
                for (int g4 = 0; g4 < 4; ++g4) { const int dv0 = 32 * mt + 8 * g4 + 4 * h; const u32x2 gw = gpre[mt][g4]; const f32x4 nv = *(const f32x4*)(gn + dv0);
                    const float g0 = siluf(bflo(gw.x)), g1 = siluf(bfhi(gw.x)), g2 = siluf(bflo(gw.y)), g3 = siluf(bfhi(gw.y));
                    u32x2 w; w.x = pk2(oT[mt][4 * g4] * rs * nv[0] * g0, oT[mt][4 * g4 + 1] * rs * nv[1] * g1);
                    w.y = pk2(oT[mt][4 * g4 + 2] * rs * nv[2] * g2, oT[mt][4 * g4 + 3] * rs * nv[3] * g3);
                    *(u32x2*)(yo + dv0) = w; }
        }
        __builtin_amdgcn_sched_barrier(0);
#pragma unroll
        for (int mt = 0; mt < 2; ++mt)
#pragma unroll
            for (int nt = 0; nt < 2; ++nt) {
                __builtin_amdgcn_sched_barrier(0);
#pragma unroll
                for (int ks = 0; ks < 2; ++ks) { const bf16x8 av = *(const LAS bf16x8*)(KT + (32 * mt + r) * 40 + 16 * ks + 8 * h), bv = *(const LAS bf16x8*)(VT + (32 * nt + r) * 40 + 16 * ks + 8 * h);
                    S[mt][nt] = __builtin_amdgcn_mfma_f32_32x32x16_bf16(av, bv, S[mt][nt], 0, 0, 0); } }
        __builtin_amdgcn_sched_barrier(0);
#pragma unroll
        for (int mt = 0; mt < 2; ++mt)
#pragma unroll
            for (int g4 = 0; g4 < 4; ++g4) { const f32x4 be = *(const LAS f32x4*)(BE + 32 * mt + 8 * g4 + 4 * h);
#pragma unroll
                for (int i = 0; i < 4; ++i) { const float eb = __expf(be[i]);
#pragma unroll
                    for (int nt = 0; nt < 2; ++nt) S[mt][nt][4 * g4 + i] *= eb; } }
        if (OUT) {
            LDS_FENCE();
#pragma unroll
            for (int mt = 0; mt < 2; ++mt)
#pragma unroll
                for (int nt = 0; nt < 2; ++nt)
#pragma unroll
                    for (int g4 = 0; g4 < 4; ++g4) { u32x2 w; w.x = pk2(S[mt][nt][4 * g4], S[mt][nt][4 * g4 + 1]); w.y = pk2(S[mt][nt][4 * g4 + 2], S[mt][nt][4 * g4 + 3]);
                        *(LAS u32x2*)(ST + (32 * nt + r) * 72 + 32 * mt + 8 * g4 + 4 * h) = w; }
        }
        LDS_FENCE();
    }
    if (!OUT) {
        float* sl = SLOC + (size_t)item * 4096;
#pragma unroll
        for (int mt = 0; mt < 2; ++mt)
#pragma unroll
            for (int nt = 0; nt < 2; ++nt)
#pragma unroll
                for (int e = 0; e < 16; ++e) sl[(32 * mt + (e & 3) + 8 * (e >> 2) + 4 * h) * 64 + 32 * nt + r] = S[mt][nt][e];
        DTOT[(size_t)item * 64 + lane] = __expf(btot);
    }
}

template <bool OUT>
__device__ __forceinline__ void s5_item(const Ctx& a, int layer, int item, LAS unsigned char* wl, int lane) {
    unsigned char* ws = a.ws;
    const int g = item & 15, sc = (item >> 4) & 15, b = item >> 8;
    const bf16_t* Z = (const bf16_t*)(ws + WS_Z);
    bf16_t* ACT = (bf16_t*)(ws + WS_ACT5);
    const float* P = (const float*)(ws + SM_S5P) + ((size_t)(layer * 16 + g) * 64 + lane) * 4;
    const float lbr = P[0], lbi = P[1], lsr = P[2], lsi = P[3];
    const float* bbp = (const float*)(ws + SM_BB) + ((size_t)(layer * 16 + g) * 64 + lane) * 32;
    float bbr[16], bbi[16];
#pragma unroll
    for (int p = 0; p < 16; p += 4) { const f32x4 x = *(const f32x4*)(bbp + p), y = *(const f32x4*)(bbp + 16 + p);
#pragma unroll
        for (int i = 0; i < 4; ++i) { bbr[p + i] = x[i]; bbi[p + i] = y[i]; } }
    float* S5L = (float*)(ws + SM_S5L);
    float hr = 0.f, hi = 0.f;
    if (OUT) for (int j = 0; j < sc; ++j) { const f32x2 lc = *(const f32x2*)(S5L + ((size_t)((b * 16 + j) * 16 + g) * 64 + lane) * 2);
        const float nr = lsr * hr - lsi * hi + lc[0], ni = lsr * hi + lsi * hr + lc[1]; hr = nr; hi = ni; }
    LAS float* ul = (LAS float*)wl; LAS bf16_t* hb = (LAS bf16_t*)(wl + 1024);
    const int fr = lane & 15, fq = lane >> 4;
    bf16x8 cf[4]; float dval = 0.f;
    if (OUT) { const bf16_t* cm = (const bf16_t*)(ws + SM_CM) + ((size_t)(layer * 16 + g) * 16 + fr) * 128;
#pragma unroll
        for (int ks = 0; ks < 4; ++ks) cf[ks] = *(const bf16x8*)(cm + 32 * ks + 8 * fq);
        dval = a.in(I_S5D)[layer * 256 + 16 * g + fr]; }
    const size_t tok0 = (size_t)b * SEQ + (size_t)sc * 512;
    for (int sub = 0; sub < 32; ++sub) {
        { const int tk = lane >> 2, p0 = (lane & 3) * 4; const u32x2 w = *(const u32x2*)(Z + (tok0 + sub * 16 + tk) * INC + 2560 + 16 * g + p0);
          *(LAS f32x4*)(ul + tk * 16 + p0) = (f32x4){bflo(w.x), bfhi(w.x), bflo(w.y), bfhi(w.y)}; }
        LDS_FENCE();
#pragma unroll 4
        for (int t = 0; t < 16; ++t) {
            float br0 = 0.f, br1 = 0.f, bi0 = 0.f, bi1 = 0.f;
#pragma unroll
            for (int p = 0; p < 16; p += 4) { const f32x4 u = *(const LAS f32x4*)(ul + t * 16 + p);
                br0 += bbr[p] * u[0] + bbr[p + 2] * u[2]; br1 += bbr[p + 1] * u[1] + bbr[p + 3] * u[3];
                bi0 += bbi[p] * u[0] + bbi[p + 2] * u[2]; bi1 += bbi[p + 1] * u[1] + bbi[p + 3] * u[3]; }
            const float nr = lbr * hr - lbi * hi + (br0 + br1), ni = lbr * hi + lbi * hr + (bi0 + bi1); hr = nr; hi = ni;
            if (OUT) { hb[t * 136 + lane] = f2bf(hr); hb[t * 136 + 64 + lane] = f2bf(hi); }
        }
        if (OUT) {
            LDS_FENCE();
            f32x4 acc = (f32x4){0.f, 0.f, 0.f, 0.f};
#pragma unroll
            for (int ks = 0; ks < 4; ++ks) { const bf16x8 av = *(const LAS bf16x8*)(hb + fr * 136 + 32 * ks + 8 * fq); acc = __builtin_amdgcn_mfma_f32_16x16x32_bf16(av, cf[ks], acc, 0, 0, 0); }
#pragma unroll
            for (int e = 0; e < 4; ++e) { const int tk = fq * 4 + e; const float y = acc[e] + dval * ul[tk * 16 + fr];
                ACT[(tok0 + sub * 16 + tk) * 256 + 16 * g + fr] = f2bf(gelu_t(y)); }
        }
        LDS_FENCE();
    }
    if (!OUT) *(f32x2*)(S5L + ((size_t)((b * 16 + sc) * 16 + g) * 64 + lane) * 2) = (f32x2){hr, hi};
}

template <bool OUT>
__device__ __forceinline__ void s5m_item(const Ctx& a, int layer, int item, LAS unsigned char* wl, int lane) {
    unsigned char* ws = a.ws;
    const int g = item & 15, sc = (item >> 4) & 15, b = item >> 8;
    const bf16_t* Z = (const bf16_t*)(ws + WS_Z);
    bf16_t* ACT = (bf16_t*)(ws + WS_ACT5);
    const float* P = (const float*)(ws + SM_S5P) + ((size_t)(layer * 16 + g) * 64 + lane) * 4;
    const float lbr = P[0], lbi = P[1], lsr = P[2], lsi = P[3];
    const int fr = lane & 15, fq = lane >> 4;
    const bf16x8 zero8 = (bf16x8){0, 0, 0, 0, 0, 0, 0, 0};
    bf16x8 bfr[8];
    { const float* bbg = (const float*)(ws + SM_BB) + (size_t)(layer * 16 + g) * 64 * 32;
#pragma unroll
      for (int j = 0; j < 8; ++j) { bfr[j] = zero8;
          if (fq < 2) { const float* src = bbg + (16 * (j & 3) + fr) * 32 + (j >= 4 ? 16 : 0) + 8 * fq; const f32x4 x0 = *(const f32x4*)src, x1 = *(const f32x4*)(src + 4);
              u32x4 w; w.x = pk2(x0[0], x0[1]); w.y = pk2(x0[2], x0[3]); w.z = pk2(x1[0], x1[1]); w.w = pk2(x1[2], x1[3]); bfr[j] = __builtin_bit_cast(bf16x8, w); } } }
    float* S5L = (float*)(ws + SM_S5L);
    float hr = 0.f, hi = 0.f;
    if (OUT) for (int j = 0; j < sc; ++j) { const f32x2 lc = *(const f32x2*)(S5L + ((size_t)((b * 16 + j) * 16 + g) * 64 + lane) * 2);
        const float nr = lsr * hr - lsi * hi + lc[0], ni = lsr * hi + lsi * hr + lc[1]; hr = nr; hi = ni; }
    LAS bf16_t* BU = (LAS bf16_t*)wl; LAS bf16_t* hb = (LAS bf16_t*)wl;
    bf16x8 cf[4]; float dval = 0.f;
    if (OUT) { const bf16_t* cm = (const bf16_t*)(ws + SM_CM) + ((size_t)(layer * 16 + g) * 16 + fr) * 128;
#pragma unroll
        for (int ks = 0; ks < 4; ++ks) cf[ks] = *(const bf16x8*)(cm + 32 * ks + 8 * fq);
        dval = a.in(I_S5D)[layer * 256 + 16 * g + fr]; }
    const size_t tok0 = (size_t)b * SEQ + (size_t)sc * 512;
    const bf16_t* zu = Z + tok0 * INC + 2560 + 16 * g;
    const u32x4 zero4 = (u32x4){0u, 0u, 0u, 0u};
    float one = 1.f; asm volatile("" : "+v"(one));
    u32x4 au = zero4;
    if (fq < 2) au = *(const u32x4*)(zu + (size_t)fr * INC + 8 * fq);
#pragma unroll 1
    for (int sub = 0; sub < 32; ++sub) {
        const bf16x8 afr = __builtin_bit_cast(bf16x8, au);
        if (OUT && fq < 2) { LAS float* up_ = (LAS float*)(wl + 4352) + fr * 16 + 8 * fq;
            *(LAS f32x4*)up_ = (f32x4){bflo(au.x), bfhi(au.x), bflo(au.y), bfhi(au.y)}; *(LAS f32x4*)(up_ + 4) = (f32x4){bflo(au.z), bfhi(au.z), bflo(au.w), bfhi(au.w)}; }
        if (sub + 1 < 32 && fq < 2) au = *(const u32x4*)(zu + (size_t)((sub + 1) * 16 + fr) * INC + 8 * fq);
        f32x4 bacc[8];
#pragma unroll
        for (int j = 0; j < 8; ++j) { bacc[j] = (f32x4){0.f, 0.f, 0.f, 0.f}; bacc[j] = __builtin_amdgcn_mfma_f32_16x16x32_bf16(afr, bfr[j], bacc[j], 0, 0, 0); }
#pragma unroll
        for (int j = 0; j < 8; ++j) { const f32x4 bs = bacc[j] * one; u32x2 w; w.x = pk2(bs[0], bs[1]); w.y = pk2(bs[2], bs[3]); *(LAS u32x2*)(BU + (16 * j + fr) * 16 + 4 * fq) = w; }
        LDS_FENCE();
        u32x4 rr[2], ri[2];
        rr[0] = *(const LAS u32x4*)(BU + lane * 16); rr[1] = *(const LAS u32x4*)(BU + lane * 16 + 8); ri[0] = *(const LAS u32x4*)(BU + (64 + lane) * 16); ri[1] = *(const LAS u32x4*)(BU + (64 + lane) * 16 + 8);
        LDS_FENCE();
#pragma unroll
        for (int t = 0; t < 16; ++t) {
            const unsigned wr_ = rr[t >> 3][(t >> 1) & 3], wi_ = ri[t >> 3][(t >> 1) & 3];
            const float br = (t & 1) ? bfhi(wr_) : bflo(wr_), bi = (t & 1) ? bfhi(wi_) : bflo(wi_);
            const float nr = lbr * hr - lbi * hi + br, ni = lbr * hi + lbi * hr + bi; hr = nr; hi = ni;
            if (OUT) { hb[t * 136 + lane] = f2bf(hr); hb[t * 136 + 64 + lane] = f2bf(hi); }
        }
        if (OUT) {
            LDS_FENCE();
            f32x4 acc = (f32x4){0.f, 0.f, 0.f, 0.f};
#pragma unroll
            for (int ks = 0; ks < 4; ++ks) { const bf16x8 av = *(const LAS bf16x8*)(hb + fr * 136 + 32 * ks + 8 * fq); acc = __builtin_amdgcn_mfma_f32_16x16x32_bf16(av, cf[ks], acc, 0, 0, 0); }
#pragma unroll
            for (int e = 0; e < 4; ++e) { const int tk = fq * 4 + e; const float uu = ((const LAS float*)(wl + 4352))[tk * 16 + fr]; const float y = acc[e] + dval * uu;
                ACT[(tok0 + sub * 16 + tk) * 256 + 16 * g + fr] = f2bf(gelu_t(y)); }
            LDS_FENCE();
        }
    }
    if (!OUT) *(f32x2*)(S5L + ((size_t)((b * 16 + sc) * 16 + g) * 64 + lane) * 2) = (f32x2){hr, hi};
}

template <bool OUT>
__device__ __forceinline__ void lru_item(const Ctx& a, int layer, int item, int lane) {
    unsigned char* ws = a.ws;
    const int cg4 = item & 3, sc = (item >> 2) & 63, b = item >> 8;
    const int c = 64 * cg4 + lane;
    const bf16_t* G = (const bf16_t*)(ws + WS_LG); const bf16_t* XC = (const bf16_t*)(ws + WS_X); const bf16_t* Z = (const bf16_t*)(ws + WS_Z);
    bf16_t* YC = (bf16_t*)(ws + WS_P);
    float* LL = (float*)(ws + SM_LL);
    const float lam = a.in(I_LAM)[layer * 256 + c];
    const float la = -8.f * log1pf(__expf(-lam));
    float hst = 0.f, ap = 1.f;
    if (OUT) for (int j = 0; j < sc; ++j) { const f32x2 lc = *(const f32x2*)(LL + ((size_t)(b * 64 + j) * 256 + c) * 2); hst = lc[0] * hst + lc[1]; }
    const size_t tok0 = (size_t)b * SEQ + (size_t)sc * 128;
#pragma unroll 8
    for (int t = 0; t < 128; ++t) {
        const size_t tk = tok0 + t;
        const float rg = bf2f(G[tk * 512 + c]), ig = bf2f(G[tk * 512 + 256 + c]), xc = bf2f(XC[tk * 256 + c]);
        const float loga = rg * la; const float av = __expf(loga); const float x2 = 2.f * loga;
        const float m1 = (x2 > -0.1f) ? -x2 * (1.f + x2 * 0.5f * (1.f + x2 * (1.f / 3.f) * (1.f + x2 * 0.25f * (1.f + x2 * 0.2f)))) : 1.f - av * av;
        const float uu = sqrtf(m1) * ig * xc;
        hst = av * hst + uu; ap *= av;
        if (OUT) { const float xg = bf2f(Z[tk * INC + 2048 + c]); YC[tk * D + 512 + c] = f2bf(hst * gelu_t(xg)); }
    }
    if (!OUT) *(f32x2*)(LL + ((size_t)(b * 64 + sc) * 256 + c) * 2) = (f32x2){ap, hst};
}

__device__ __forceinline__ void prologue_phase(const Ctx& a, LAS unsigned char* lds, int tid, int lane, int wid, int bx, int G, int gw, int NGW) {
    unsigned char* ws = a.ws; float* X = (float*)a.in(39); bf16_t* H = (bf16_t*)(ws + WS_H);

            LAS float* scr = (LAS float*)(lds + wid * 8448);
            constexpr int C0 = 1408, C1 = C0 + 2048, C2 = C1 + 512, C6 = C2 + 512, C7 = C6 + 32, C8 = C7 + 512, C9 = C8 + 1024, C10 = C9 + 512, C11 = C10 + 2816, CT = C11 + 1408;
#pragma unroll 1
            for (int gi = gw; gi < NL * CT; gi += NGW) {
                const int l = gi / CT, r = gi % CT;
                unsigned char* wl = ws + WS_W + l * WL_STRIDE;
                const float* W; int ldw, K, N, mode = 0, it; bf16_t* WT;
                if (r < C0) { it = r; W = a.in(I_WIN) + (size_t)l * D * INC; ldw = INC; K = D; N = INC; WT = (bf16_t*)(wl + OW_IN); }
                else if (r < C1) { it = r - C0; W = a.in(I_WGATE) + (size_t)l * D * 4096; ldw = 4096; K = D; N = 4096; WT = (bf16_t*)(wl + OW_GATE); mode = 1; }
                else if (r < C2) { const int q = r - C1, nb = q >> 7; it = q & 127; W = a.in(I_WUP) + ((size_t)l * 4 + nb) * 256 * D; ldw = D; K = 256; N = D; WT = (bf16_t*)(wl + OW_UP) + (size_t)nb * 1024 * 256; }
                else if (r < C6) { it = r - C2; W = a.in(I_WOUT) + (size_t)l * D * D; ldw = D; K = D; N = D; WT = (bf16_t*)(wl + OW_OUT); }
                else if (r < C7) { it = r - C6; W = a.in(I_GLUW) + (size_t)l * 256 * 256; ldw = 256; K = 256; N = 256; WT = (bf16_t*)(wl + OW_GLU); }
                else if (r < C8) { it = r - C7; W = a.in(I_WQ) + (size_t)l * D * D; ldw = D; K = D; N = D; WT = (bf16_t*)(wl + OW_Q); }
                else if (r < C9) { it = r - C8; W = a.in(I_WKV) + (size_t)l * D * 2048; ldw = 2048; K = D; N = 2048; WT = (bf16_t*)(wl + OW_KV); }
                else if (r < C10) { it = r - C9; W = a.in(I_WO) + (size_t)l * D * D; ldw = D; K = D; N = D; WT = (bf16_t*)(wl + OW_O); }
                else if (r < C11) { it = r - C10; W = a.in(I_WGU) + (size_t)l * D * 2 * FF; ldw = 2 * FF; K = D; N = 2 * FF; WT = (bf16_t*)(wl + OW_GU); mode = 2; }
                else { it = r - C11; W = a.in(I_WDOWN) + (size_t)l * FF * D; ldw = D; K = FF; N = D; WT = (bf16_t*)(wl + OW_DOWN); }
                transpose_item(W, ldw, K, N, WT, mode, scr, it, lane);
            }
            const int NT = G * 512, gt = NT - 1 - (bx * 512 + tid);
            for (int i = gt; i < NL * 512 * 256; i += NT) { const int l = i / (512 * 256), rem = i % (512 * 256), n = rem >> 8, k = rem & 255, ch = n & 255, blk = ch >> 6;
                float v = 0.f; if ((k >> 6) == blk) v = a.in(n < 256 ? I_WA : I_WX)[((size_t)(l * 4 + blk) * 64 + (k & 63)) * 64 + (ch & 63)];
                ((bf16_t*)(ws + WS_W + l * WL_STRIDE + OW_LRU))[rem] = f2bf(v); }
            for (int i = gt; i < NL * 512; i += NT) { const int l = i >> 9, n = i & 511; ((float*)(ws + SM_LB))[i] = a.in(n < 256 ? I_BA : I_BX)[l * 256 + (n & 255)]; }
            for (int i = gt; i < SEQ * 32; i += NT) { const int pos = i >> 5, f = i & 31; const double inv = exp2(-(double)f * (13.287712379549449 / 32.0)); float s, c; sincos_acc((double)pos * inv, s, c);
                ((float*)(ws + SM_COS))[i] = c; ((float*)(ws + SM_SIN))[i] = s; }
            for (int i = gt; i < NL * 16 * 64; i += NT) { const int l = i >> 10, g = (i >> 6) & 15;
                const float lre = a.in(I_S5LRE)[i], lim = a.in(I_S5LIM)[i]; const float step = expf(a.in(I_S5LDT)[l * 16 + g]);
                const float mag = expf(lre * step); float s, c; sincos_acc((double)(lim * step), s, c);
                const float lbr = mag * c, lbi = mag * s; const float den = lre * lre + lim * lim;
                const float fre = ((lbr - 1.f) * lre + lbi * lim) / den, fim = (lbi * lre - (lbr - 1.f) * lim) / den;
                const float magS = expf(512.f * lre * step); float s2, c2; sincos_acc(512.0 * (double)(lim * step), s2, c2);
                float* P = (float*)(ws + SM_S5P) + (size_t)i * 4; P[0] = lbr; P[1] = lbi; P[2] = magS * c2; P[3] = magS * s2;
                float* bb = (float*)(ws + SM_BB) + (size_t)i * 32;
                for (int p = 0; p < 16; ++p) { const float bre = a.in(I_S5BRE)[(size_t)i * 16 + p], bim = a.in(I_S5BIM)[(size_t)i * 16 + p]; bb[p] = fre * bre - fim * bim; bb[16 + p] = fre * bim + fim * bre; } }
            for (int i = gt; i < NL * 16 * 16 * 128; i += NT) { const int k = i & 127, lgp = i >> 7;
                const float v = (k < 64) ? a.in(I_S5CRE)[(size_t)lgp * 64 + k] : -a.in(I_S5CIM)[(size_t)lgp * 64 + (k - 64)];
                ((bf16_t*)(ws + SM_CM))[i] = f2bf(v); }
            for (int l = 0; l < NL; ++l) addnorm_rows<false, false>(a.in(I_MEM), nullptr, nullptr, nullptr, a.in(I_NMEM) + l * D, (bf16_t*)(ws + SM_MN) + (size_t)l * 2048 * D, 2048, gw, NGW, lane);
            addnorm_rows<false, true>(a.in(I_X), (bf16_t*)(ws + WS_XB), nullptr, nullptr, a.in(I_NMIXPRE), H, T, gw, NGW, lane);
}

#define XB_TMO      128
#define XB_XCNT(j)  (256  + 64 * (j))
#define XB_XSUB(j)  (1280 + 64 * (j))
#define XB_XGEN(j)  (2304 + 64 * (j))
#define XB_TOP      3328
#define XB_TOPGEN   3392
#define XCD_BAR_WORDS 3456
#define XB_SPIN_CAP (1u << 18)

__device__ __forceinline__ unsigned xb_ld(unsigned* p)              { return __hip_atomic_load(p, __ATOMIC_RELAXED, __HIP_MEMORY_SCOPE_AGENT); }
__device__ __forceinline__ unsigned xb_add(unsigned* p, unsigned v) { return __hip_atomic_fetch_add(p, v, __ATOMIC_RELAXED, __HIP_MEMORY_SCOPE_AGENT); }
__device__ __forceinline__ unsigned xb_xcc_id() { return (unsigned)__builtin_amdgcn_s_getreg((3 << 11) | 20) & 0xFu; }
#define XB_SPIN(cond, bar) do { unsigned _sp = 0; while (cond) { __builtin_amdgcn_s_sleep(1); \
    if ((++_sp & 255u) == 0u) { if (xb_ld(&(bar)[XB_TMO])) break; if (_sp > XB_SPIN_CAP) { atomicAdd(&(bar)[XB_TMO], 1u); break; } } } } while (0)

struct XcdBarrier {
    unsigned* bar; unsigned x;
    volatile LAS unsigned* st;
};

__device__ __forceinline__ XcdBarrier xcd_barrier_post(unsigned* bar, volatile LAS unsigned* st) {
    XcdBarrier b; b.bar = bar; b.x = xb_xcc_id(); b.st = st;
    if (threadIdx.x == 0) (void)xb_add(&bar[XB_XCNT(b.x)], 1u);
    return b;
}
__device__ __forceinline__ void xcd_barrier_complete(unsigned* bar, unsigned x, unsigned& nloc, unsigned& nx) {
    const unsigned G = gridDim.x * gridDim.y * gridDim.z;
    unsigned sum, cnt, mine, sp = 0u;
    for (;;) {
        sum = 0u; cnt = 0u; mine = 0u;
#pragma unroll
        for (unsigned j = 0; j < 16; ++j) { const unsigned c = xb_ld(&bar[XB_XCNT(j)]); sum += c; cnt += (c > 0u) ? 1u : 0u; mine = (j == x) ? c : mine; }
        if (sum == G) break;
        __builtin_amdgcn_s_sleep(1);
        if ((++sp & 255u) == 0u) { if (xb_ld(&bar[XB_TMO])) break; if (sp > XB_SPIN_CAP) { atomicAdd(&bar[XB_TMO], 1u); break; } }
    }
    nloc = mine > 0u ? mine : 1u; nx = cnt > 0u ? cnt : 1u;
}

__device__ __forceinline__ void xcd_barrier(const XcdBarrier& b) {
    asm volatile("s_waitcnt vmcnt(0)" ::: "memory");
    __syncthreads();
    if (threadIdx.x == 0) {
        unsigned* bar = b.bar;
        __builtin_amdgcn_s_waitcnt(0);
        unsigned nloc = b.st[0], nx = b.st[1];
        if (nloc == 0u) { xcd_barrier_complete(bar, b.x, nloc, nx); b.st[0] = nloc; b.st[1] = nx; }
        const unsigned old = xb_add(&bar[XB_XSUB(b.x)], 1u);
        const unsigned gen = old / nloc;
        if (old + 1u == (gen + 1u) * nloc) {
            __builtin_amdgcn_fence(__ATOMIC_RELEASE, "agent");
            asm volatile("s_waitcnt vmcnt(0)" ::: "memory");
            const unsigned og = xb_add(&bar[XB_TOP], 1u);
            const unsigned tg = og / nx;
            if (og + 1u == (tg + 1u) * nx) xb_add(&bar[XB_TOPGEN], 1u);
            else XB_SPIN(xb_ld(&bar[XB_TOPGEN]) == tg, bar);
            __builtin_amdgcn_fence(__ATOMIC_ACQUIRE, "agent");
            xb_add(&bar[XB_XGEN(b.x)], 1u);
            asm volatile("s_waitcnt vmcnt(0)" ::: "memory");
        } else {
            XB_SPIN(xb_ld(&bar[XB_XGEN(b.x)]) == gen, bar);
            __builtin_amdgcn_fence(__ATOMIC_ACQUIRE, "agent");
            asm volatile("s_waitcnt vmcnt(0)" ::: "memory");
        }
    }
    __syncthreads();
}

__global__ void __launch_bounds__(512, 2) mega(Args kargs) {
    extern __shared__ __attribute__((aligned(16))) unsigned char lds_raw[];
    LAS unsigned char* lds = (LAS unsigned char*)lds_raw;
    LAS unsigned long long* ptw = (LAS unsigned long long*)(lds + LDS_BYTES);
    if (threadIdx.x == 0) {
#pragma unroll
        for (int i = 0; i < 39; ++i) ptw[i] = (unsigned long long)kargs.in[i];
        ptw[39] = (unsigned long long)kargs.out; ptw[40] = (unsigned long long)kargs.ws;
        ((LAS unsigned*)(lds + LDS_BYTES + 384))[0] = 0u; ((LAS unsigned*)(lds + LDS_BYTES + 384))[1] = 0u;
    }
    __syncthreads();
    const int ph_lo = kargs.ph_lo, ph_hi = kargs.ph_hi;
    if (ph_hi < 0) cg::this_grid().sync();
    XcdBarrier xbar = xcd_barrier_post((unsigned*)((unsigned char*)kargs.ws + WS_CTL), (volatile LAS unsigned*)(lds + LDS_BYTES + 384));
    if (ph_lo >= 100) {
        const float* src = (const float*)((unsigned char*)kargs.ws + WS_Z); const bf16_t* srcb = (const bf16_t*)((unsigned char*)kargs.ws + (ph_lo == 101 ? WS_Q : (ph_lo == 102 ? WS_P : (ph_lo == 104 ? WS_H : (ph_lo == 105 ? WS_Z : SM_KM)))));
        for (size_t i = (size_t)blockIdx.x * 512 + threadIdx.x; i < (size_t)T * D; i += (size_t)gridDim.x * 512) kargs.out[i] = (ph_lo == 100) ? src[i] : ((ph_lo == 103 && i >= (size_t)4 * 1024 * 1024) ? 0.f : 64.f * bf2f(srcb[i]));
        return;
    }
    if (ph_lo == 0) {
        int tid = threadIdx.x; asm volatile("" : "+v"(tid));
        Ctx a; a.pt = ptw; a.ws = (unsigned char*)a.in(40);
        const int lane = tid & 63, wid = __builtin_amdgcn_readfirstlane(tid >> 6);
        const int G = gridDim.x, bx = blockIdx.x;
        if (PEN(31)) prologue_phase(a, lds, tid, lane, wid, bx, G, bx * 8 + wid, G * 8);
        if (ph_hi > 1) xcd_barrier(xbar);
    }
#pragma unroll 1
    for (int ph = (ph_lo > 1 ? ph_lo : 1); ph < ph_hi; ++ph) {
        int tid = threadIdx.x; asm volatile("" : "+v"(tid));
        Ctx a; a.pt = ptw; a.ws = (unsigned char*)a.in(40);
        unsigned char* ws = a.ws;
        const int lane = tid & 63, wid = __builtin_amdgcn_readfirstlane(tid >> 6);
        int G = gridDim.x, bx = blockIdx.x; asm volatile("" : "+s"(G), "+s"(bx));
        const int gw = bx * 8 + wid, NGW = G * 8;
        float* X = (float*)a.in(39);
        bf16_t* H = (bf16_t*)(ws + WS_H); bf16_t* Zb = (bf16_t*)(ws + WS_Z); bf16_t* Qb = (bf16_t*)(ws + WS_Q); bf16_t* Xb = (bf16_t*)(ws + WS_X); bf16_t* Pb = (bf16_t*)(ws + WS_P);
        {
            const int l = (ph - 1) / NSUB, sp = SPSEQ[(ph - 1) % NSUB];
            unsigned char* wl = ws + WS_W + l * WL_STRIDE;
            using pg8::GS;
            switch (sp) {
            case 0: if (PEN(0)) {
                pg8::EpiBf16<0, INC> E{Zb, nullptr, nullptr}; pg8::gemm_phase<GS<T, INC, D, D, D>>(tid, lds, H, (const bf16_t*)(wl + OW_IN), bx, E);
            } break;
            case 1: if (PEN(1)) {
                if (wid < 4) { if (PEN(23)) gla_item<false>(a, l, bx * 4 + wid, lds + wid * GL_BYTES, lane); }
                else {
                    const int w4 = bx * 4 + (wid - 4);
                    if (PEN(24)) {
                    const float* cw = a.in(I_CONVW) + l * 4 * 256; const float* cb = a.in(I_CONVB) + l * 256;
                    for (int v = w4 * 64 + lane; v < T * 32; v += G * 4 * 64) {
                        const int t = v >> 5, c8 = (v & 31) * 8, s = t & (SEQ - 1);
                        float acc[8];
#pragma unroll
                        for (int i = 0; i < 8; ++i) acc[i] = cb[c8 + i];
#pragma unroll
                        for (int j = 0; j < 4; ++j) { if (s - 3 + j >= 0) { const u32x4 w = *(const u32x4*)(Zb + (size_t)(t - 3 + j) * INC + 2304 + c8); const float* wj = cw + j * 256 + c8;
                            acc[0] += wj[0] * bflo(w.x); acc[1] += wj[1] * bfhi(w.x); acc[2] += wj[2] * bflo(w.y); acc[3] += wj[3] * bfhi(w.y);
                            acc[4] += wj[4] * bflo(w.z); acc[5] += wj[5] * bfhi(w.z); acc[6] += wj[6] * bflo(w.w); acc[7] += wj[7] * bfhi(w.w); } }
                        u32x4 o; o.x = pk2(acc[0], acc[1]); o.y = pk2(acc[2], acc[3]); o.z = pk2(acc[4], acc[5]); o.w = pk2(acc[6], acc[7]);
                        *(u32x4*)(Xb + (size_t)t * 256 + c8) = o;
                    } }
                }
                s5m_item<false>(a, l, bx * 8 + wid, wid < 4 ? lds + wid * GL_BYTES : lds + S5_OFF + (wid - 4) * S5_BYTES, lane);
            } break;
            case 2: if (PEN(2)) {
                if (PEN(20)) { pg8::EpiBf16<1, 512> E{(bf16_t*)(ws + WS_LG), (const float*)(ws + SM_LB) + l * 512, nullptr};
                  pg8::gemm_phase<GS<T, 512, 256, 256, 256>>(tid, lds, Xb, (const bf16_t*)(wl + OW_LRU), bx, E); }
                float* SLOC = (float*)(ws + SM_SLOC); const float* DTOT = (const float*)(ws + SM_DTOT);
                for (int v = bx * 512 + tid; v < 64 * 4096; v += G * 512) {
                    const int e = v & 4095, combo = v >> 12, hh = combo & 3, mx = (combo >> 2) & 1, b = combo >> 3;
                    float st = 0.f;
#pragma unroll 4
                    for (int j = 0; j < 16; ++j) { const int itj = (b << 7) | (j << 3) | (mx << 2) | hh; float* p = SLOC + (size_t)itj * 4096 + e; const float loc = *p; const float dd = DTOT[(size_t)itj * 64 + (e >> 6)];
                        *p = st; st = dd * st + loc; }
                }
            } break;
            case 3: if (PEN(3)) {
                if (wid < 4) { if (PEN(21)) gla_item<true>(a, l, bx * 4 + wid, lds + wid * GL_BYTES, lane); }
                else { lru_item<false>(a, l, bx * 4 + (wid - 4), lane); lru_item<false>(a, l, 1024 + bx * 4 + (wid - 4), lane); }
                s5m_item<true>(a, l, bx * 8 + wid, wid < 4 ? lds + wid * GL_BYTES : lds + S5_OFF + (wid - 4) * S5_BYTES, lane);
            } break;
            case 4: if (PEN(4)) {
                { pg8::EpiBf16<2, D, 256> E{Pb + 768, a.in(I_GLUB) + l * 256, (const bf16_t*)(ws + WS_ACT5)};
                  pg8::gemm_phase<GS<T, 256, 256, 256, 256>>(tid, lds, (const bf16_t*)(ws + WS_ACT5), (const bf16_t*)(wl + OW_GLU), bx, E); }
                { pg8::EpiBf16<3, D> E{(bf16_t*)(ws + SM_KM), nullptr, nullptr};
                  pg8::gemm_phase<GS<2048, 1024, D, D, D>>(tid, lds, (const bf16_t*)(ws + SM_MN) + (size_t)l * 2048 * D, (const bf16_t*)(wl + OW_KV), bx, E); }
                { pg8::EpiBf16<0, 2048> E{(bf16_t*)(ws + SM_VT), nullptr, nullptr};
                  pg8::gemm_phase<GS<1024, 2048, D, D, D>>(tid, lds, (const bf16_t*)(wl + OW_KV) + (size_t)1024 * D, (const bf16_t*)(ws + SM_MN) + (size_t)l * 2048 * D, (bx + 128) & 255, E); }
                lru_item<true>(a, l, gw, lane);
            } break;
            case 5: if (PEN(5)) { lru_item<true>(a, l, gw, lane); } break;
            case 6: if (PEN(6)) {
                pg8::EpiBf16<0, 4096> E{Zb, nullptr, nullptr}; pg8::gemm_phase<GS<T, 4096, 256, D, 256, 4, 256>>(tid, lds, Pb, (const bf16_t*)(wl + OW_UP), bx, E);
            } break;
            case 7: if (PEN(7)) {
                pg8::EpiMix E{Pb, a.in(I_BGATE) + l * 4096, Zb}; pg8::gemm_phase<GS<T, 4096, D, D, D>>(tid, lds, H, (const bf16_t*)(wl + OW_GATE), bx, E);
            } break;
            case 8: if (PEN(8)) {
                pg8::EpiBf16<0, D> E{H, nullptr, nullptr}; pg8::gemm_phase<GS<T, D, D, D, D>>(tid, lds, Pb, (const bf16_t*)(wl + OW_OUT), bx, E);
            } break;
            case 9: if (PEN(9)) addnorm_rows<true, true>(ws + WS_XB, ws + WS_XB, H, a.in(I_NMIXPOST) + l * D, a.in(I_NXAPRE) + l * D, H, T, gw, NGW, lane); break;
            case 10: if (PEN(10)) {
                pg8::EpiBf16<0, D> E{Pb, nullptr, nullptr}; pg8::gemm_phase<GS<T, D, D, D, D>>(tid, lds, H, (const bf16_t*)(wl + OW_Q), bx, E);
            } break;
            case 11: if (PEN(11)) {
                pg8::EpiBf16<0, D> E{Zb, nullptr, nullptr}; pg8::gemm_phase<GS<T, D, 256, D, D, 1, 256, 256, 32, 256L * D>>(tid, lds, Pb, (const bf16_t*)(ws + SM_KM), bx, E);
            } break;
            case 12: if (PEN(12)) {
                for (int row0 = gw; row0 < T; row0 += 2 * NGW) {
                    u32x2 sw[2][4];
#pragma unroll
                    for (int u = 0; u < 2; ++u) { const u32x2* sr = (const u32x2*)(Zb + (size_t)(row0 + u * NGW) * D) + lane;
#pragma unroll
                        for (int j = 0; j < 4; ++j) sw[u][j] = sr[64 * j]; }
#pragma unroll
                    for (int u = 0; u < 2; ++u) { u32x2* pw = (u32x2*)(Qb + (size_t)(row0 + u * NGW) * D) + lane;
#pragma unroll
                        for (int j = 0; j < 4; ++j) { f32x4 v = (f32x4){bflo(sw[u][j].x), bfhi(sw[u][j].x), bflo(sw[u][j].y), bfhi(sw[u][j].y)}; const float mx = wave_max(fmaxf(fmaxf(v[0], v[1]), fmaxf(v[2], v[3])));
                            v[0] = __expf(v[0] - mx); v[1] = __expf(v[1] - mx); v[2] = __expf(v[2] - mx); v[3] = __expf(v[3] - mx);
                            const float inv = 1.f / wave_sum((v[0] + v[1]) + (v[2] + v[3])); u32x2 w; w.x = pk2(v[0] * inv, v[1] * inv); w.y = pk2(v[2] * inv, v[3] * inv); pw[64 * j] = w; } }
                }
            } break;
            case 13: if (PEN(13)) {
                pg8::EpiBf16<0, D> E{Pb, nullptr, nullptr}; pg8::gemm_phase<GS<T, D, 256, D, 2048, 1, 256, -1, 32, 256>>(tid, lds, Qb, (const bf16_t*)(ws + SM_VT), bx, E);
            } break;
            case 14: if (PEN(14)) {
                pg8::EpiBf16<0, D> E{H, nullptr, nullptr}; pg8::gemm_phase<GS<T, D, D, D, D>>(tid, lds, Pb, (const bf16_t*)(wl + OW_O), bx, E);
            } break;
            case 15: if (PEN(15)) addnorm_rows<true, true>(ws + WS_XB, ws + WS_XB, H, a.in(I_NXAPOST) + l * D, a.in(I_NFFNPRE) + l * D, H, T, gw, NGW, lane); break;
            case 16: if (PEN(16)) {
                pg8::EpiGU E{Zb}; pg8::gemm_phase<GS<T, 2 * FF, D, D, D>>(tid, lds, H, (const bf16_t*)(wl + OW_GU), bx, E);
            } break;
            case 17: if (PEN(17)) {
                pg8::EpiBf16<0, D> E{H, nullptr, nullptr}; pg8::gemm_phase<GS<T, D, FF, FF, FF>>(tid, lds, Zb, (const bf16_t*)(wl + OW_DOWN), bx, E);
            } break;
            default:
                if (l + 1 < NL) addnorm_rows<true, true>(ws + WS_XB, ws + WS_XB, H, a.in(I_NFFNPOST) + l * D, a.in(I_NMIXPRE) + (l + 1) * D, H, T, gw, NGW, lane);
                else addnorm_rows<true, false>(ws + WS_XB, X, H, a.in(I_NFFNPOST) + l * D, nullptr, nullptr, T, gw, NGW, lane);
                break;
            }
        }
        if (ph + 1 < ph_hi) xcd_barrier(xbar);
    }
    if (DUMPPH >= 200) {
        __syncthreads(); cg::this_grid().sync();
        unsigned char* ws = (unsigned char*)kargs.ws; float* out = kargs.out;
        const size_t gt = (size_t)blockIdx.x * 512 + threadIdx.x, NT = (size_t)gridDim.x * 512;
        for (size_t i = gt; i < (size_t)T * D; i += NT) out[i] = 0.f;
        __syncthreads(); cg::this_grid().sync();
        if (DUMPPH == 201) {
            const bf16_t* H = (const bf16_t*)(ws + WS_H); const bf16_t* Z = (const bf16_t*)(ws + WS_Z); const float* W = kargs.in[I_WIN];
            const size_t s = gt; const int row = (int)((s * 7919u) % T), col = (int)((s * 104729u + 13u) % INC);
            float dot = 0.f; for (int k = 0; k < D; ++k) dot += bf2f(H[(size_t)row * D + k]) * W[(size_t)k * INC + col];
            out[s] = 1e4f * fabsf(dot - bf2f(Z[(size_t)row * INC + col]));
        }
        if (DUMPPH == 206) {
            const bf16_t* YC = (const bf16_t*)(ws + WS_P); const bf16_t* UP = (const bf16_t*)(ws + WS_Z); const float* W = kargs.in[I_WUP];
            const size_t s = gt; const int row = (int)((s * 7919u) % T), col = (int)((s * 104729u + 13u) % 4096), nb = col >> 10, c = col & 1023;
            float dot = 0.f; for (int k = 0; k < 256; ++k) dot += bf2f(YC[(size_t)row * D + nb * 256 + k]) * W[((size_t)nb * 256 + k) * D + c];
            out[s] = ENC(fabsf(dot - bf2f(UP[(size_t)row * 4096 + col])));
        }
        if (DUMPPH == 207) {
            const bf16_t* XC = (const bf16_t*)(ws + WS_X); const bf16_t* GG = (const bf16_t*)(ws + WS_LG);
            const size_t s = gt; const int row = (int)((s * 7919u) % T), col = (int)((s * 104729u + 13u) % 512), ch = col & 255, blk = ch >> 6;
            const float* wsel = kargs.in[col < 256 ? I_WA : I_WX] + (size_t)blk * 4096;
            float dot = kargs.in[col < 256 ? I_BA : I_BX][ch]; for (int i = 0; i < 64; ++i) dot += bf2f(XC[(size_t)row * 256 + 64 * blk + i]) * wsel[i * 64 + (ch & 63)];
            out[s] = ENC(fabsf(1.f / (1.f + expf(-dot)) - bf2f(GG[(size_t)row * 512 + col])));
        }
        if (DUMPPH == 208) {
            const bf16_t* GG = (const bf16_t*)(ws + WS_LG); float cnt = 0.f;
            for (size_t i = gt; i < (size_t)T * 512; i += NT) cnt += (fabsf(bf2f(GG[i])) > 1.5f) ? 1.f : 0.f;
            out[gt] = ENC(cnt);
        }
        if (DUMPPH == 202 && gt < 2048) {
            const int l = 0, b = (int)gt >> 8, c = (int)gt & 255, blk = c >> 6, cj = c & 63;
            const bf16_t* Z = (const bf16_t*)(ws + WS_Z); const bf16_t* XC = (const bf16_t*)(ws + WS_X); const bf16_t* YC = (const bf16_t*)(ws + WS_P);
            const float* cw = kargs.in[I_CONVW] + l * 1024; const float cbv = kargs.in[I_CONVB][l * 256 + c];
            const float* wa = kargs.in[I_WA] + (size_t)(l * 4 + blk) * 4096; const float* wx = kargs.in[I_WX] + (size_t)(l * 4 + blk) * 4096;
            const float bav = kargs.in[I_BA][l * 256 + c], bxv = kargs.in[I_BX][l * 256 + c];
            const float la = -8.f * log1pf(expf(-kargs.in[I_LAM][l * 256 + c]));
            float h = 0.f, md = 0.f, mdc = 0.f;
            for (int t = 0; t < SEQ; ++t) {
                const size_t tk = (size_t)b * SEQ + t;
                float xc = cbv; for (int j = 0; j < 4; ++j) if (t - 3 + j >= 0) xc += cw[j * 256 + c] * bf2f(Z[(tk - 3 + j) * INC + 2304 + c]);
                float ra = bav, rx = bxv; for (int i = 0; i < 64; ++i) { const float xv = bf2f(XC[tk * 256 + 64 * blk + i]); ra += xv * wa[i * 64 + cj]; rx += xv * wx[i * 64 + cj]; }
                const float r = 1.f / (1.f + expf(-ra)), ig = 1.f / (1.f + expf(-rx));
                { const bf16_t* GG = (const bf16_t*)(ws + WS_LG); mdc += (fabsf(bf2f(GG[tk * 512 + c])) > 1.5f) ? 1.f : 0.f; }
                const float loga = la * r; const float av = expf(loga); const float uu = sqrtf(-expm1f(2.f * loga)) * ig * xc;
                h = av * h + uu;
                const float xg = bf2f(Z[tk * INC + 2048 + c]); const float u3 = 0.7978845608f * (xg + 0.044715f * xg * xg * xg); const float ge = 0.5f * xg * (1.f + tanhf(u3));
                md = fmaxf(md, fabsf(h * ge - bf2f(YC[tk * D + 512 + c])));
            }
            out[gt] = ENC(mdc); out[4096 + gt] = 0.01f * ENC(md);
        }
        if (DUMPPH == 203 && gt < 128 * 64) {
            const int l = 0, wv = (int)(gt >> 6), lane = (int)gt & 63, b = wv >> 4, g = wv & 15;
            const bf16_t* Z = (const bf16_t*)(ws + WS_Z); const bf16_t* ACT = (const bf16_t*)(ws + WS_ACT5);
            const int pi = (l * 16 + g) * 64 + lane;
            const float lre = kargs.in[I_S5LRE][pi], lim = kargs.in[I_S5LIM][pi], step = expf(kargs.in[I_S5LDT][l * 16 + g]);
            const float mag = expf(lre * step); float sn, cs; sincos_acc((double)(lim * step), sn, cs);
            const float lbr = mag * cs, lbi = mag * sn, den = lre * lre + lim * lim;
            const float fre = ((lbr - 1.f) * lre + lbi * lim) / den, fim = (lbi * lre - (lbr - 1.f) * lim) / den;
            float hr = 0.f, hi = 0.f, md = 0.f;
            for (int t = 0; t < SEQ; ++t) {
                const size_t tk = (size_t)b * SEQ + t;
                float br = 0.f, bi = 0.f;
                for (int p = 0; p < 16; ++p) { const float u = bf2f(Z[tk * INC + 2560 + 16 * g + p]); const float bre = kargs.in[I_S5BRE][(size_t)pi * 16 + p], bim = kargs.in[I_S5BIM][(size_t)pi * 16 + p];
                    br += (fre * bre - fim * bim) * u; bi += (fre * bim + fim * bre) * u; }
                const float nr = lbr * hr - lbi * hi + br, ni = lbr * hi + lbi * hr + bi; hr = nr; hi = ni;
                for (int p = 0; p < 16; ++p) { const size_t ci = ((size_t)(l * 16 + g) * 16 + p) * 64 + lane;
                    float y = wave_sum(kargs.in[I_S5CRE][ci] * hr - kargs.in[I_S5CIM][ci] * hi);
                    const float u = bf2f(Z[tk * INC + 2560 + 16 * g + p]); y += kargs.in[I_S5D][l * 256 + 16 * g + p] * u;
                    const float u3 = 0.7978845608f * (y + 0.044715f * y * y * y); const float ge = 0.5f * y * (1.f + tanhf(u3));
                    md = fmaxf(md, fabsf(ge - bf2f(ACT[tk * 256 + 16 * g + p]))); }
            }
            if (lane == 0) out[wv] = ENC(md);
        }
        if ((DUMPPH == 204 || DUMPPH == 205) && gt < 64 * 64) {
            const int l = 0, wv = (int)(gt >> 6), lane = (int)gt & 63, hh = wv & 3, mx = (wv >> 2) & 1, b = wv >> 3;
            const bf16_t* Z = (const bf16_t*)(ws + WS_Z); const bf16_t* YC = (const bf16_t*)(ws + WS_P);
            const int cq = (mx ? 1024 : 0) + 64 * hh;
            const float lgam = log1pf(-exp2f(-5.f - (float)hh));
            float S[64];
#pragma unroll
            for (int i = 0; i < 64; ++i) S[i] = 0.f;
            float md = 0.f;
            const float* gn = kargs.in[mx ? I_RETNORM : I_HGNORM] + l * 256 + 64 * hh;
            for (int t = 0; t < 2048; ++t) {
                const size_t tk = (size_t)b * SEQ + t; const bf16_t* zt = Z + tk * INC + cq;
                float q = bf2f(zt[lane]), fv = bf2f(zt[256 + lane]), f, kk;
                if (mx == 0) { f = 1.f / (1.f + expf(-fv)); kk = 1.f - f; q = q / (1.f + expf(-q)); }
                else { const double inv = exp2(-(double)(lane >> 1) * (13.287712379549449 / 32.0)); float sn, cs; sincos_acc((double)t * inv, sn, cs);
                    const float qp = __shfl_xor(q, 1), kp = __shfl_xor(fv, 1); const float sg = (lane & 1) ? sn : -sn; q = q * cs + qp * sg; kk = (fv * cs + kp * sg) * 0.125f; f = expf(lgam); }
                float ss = 0.f; float o[64];
#pragma unroll
                for (int dv = 0; dv < 64; ++dv) { const float v = bf2f(zt[512 + dv]); S[dv] = f * S[dv] + kk * v; o[dv] = wave_sum(q * S[dv]); ss += o[dv] * o[dv]; }
                const float rs = rsqrtf(ss * (1.f / 64.f) + EPS);
#pragma unroll
                for (int dv = 0; dv < 64; ++dv) { const float gg = bf2f(zt[768 + dv]); const float val = o[dv] * rs * gn[dv] * (gg / (1.f + expf(-gg)));
                    md = fmaxf(md, fabsf(val - bf2f(YC[tk * D + 256 * mx + 64 * hh + dv]))); }
            }
            if (lane == 0 && ((DUMPPH == 204) == (mx == 0))) out[wv] = ENC(md);
        }
    }
}

extern "C" void kernel_launch(void* const* d_in, const int* in_sizes, int n_in, void* d_out, int out_size, void* d_ws, size_t ws_size, hipStream_t stream) {
    static int ready = 0;
    if (!ready) {
        if (n_in != 39 || out_size != T * D || ws_size < WS_END + 128 * MiB) { fprintf(stderr, "kernel_launch: unexpected shapes (n_in %d out %d ws %zu)\n", n_in, out_size, ws_size); ready = -1; return; }
        if (hipFuncSetAttribute((const void*)mega, hipFuncAttributeMaxDynamicSharedMemorySize, LDS_BYTES + 512) != hipSuccess) { fprintf(stderr, "kernel_launch: hipFuncSetAttribute failed\n"); ready = -1; return; }
        ready = 1;
    }
    if (ready < 0) return;
    Args a{};
    for (int i = 0; i < 39; ++i) a.in[i] = (const float*)d_in[i];
    a.out = (float*)d_out; a.ws = (unsigned char*)d_ws;
#if PER_PHASE_LAUNCH
    for (int p = 0; p < (MAXPH < NPH ? MAXPH : NPH); ++p) { a.ph_lo = p; a.ph_hi = p + 1; hipLaunchKernelGGL(mega, dim3(256), dim3(512), LDS_BYTES + 512, stream, a); }
    if (DUMPPH) { a.ph_lo = DUMPPH; a.ph_hi = DUMPPH + 1; hipLaunchKernelGGL(mega, dim3(256), dim3(512), LDS_BYTES + 512, stream, a); }
#else
    if (hipMemsetAsync((char*)d_ws + WS_CTL, 0, XCD_BAR_WORDS * sizeof(unsigned), stream) != hipSuccess) { fprintf(stderr, "kernel_launch: memset of the barrier words failed\n"); return; }
    a.ph_lo = 0; a.ph_hi = (MAXPH < NPH ? MAXPH : NPH);
    void* kargs[] = {&a};
    hipError_t e = hipLaunchCooperativeKernel((const void*)mega, dim3(256), dim3(512), kargs, LDS_BYTES + 512, stream);
    if (e != hipSuccess) fprintf(stderr, "cooperative launch failed: %s\n", hipGetErrorString(e));
#endif
}
```

```cpp
#include <hip/hip_runtime.h>
#include <hip/hip_cooperative_groups.h>
#include <cstdio>
namespace cg = cooperative_groups;

#ifndef MAXPH
#define MAXPH 1000
#endif
#ifndef DUMPPH
#define DUMPPH 0
#endif
#ifndef PER_PHASE_LAUNCH
#define PER_PHASE_LAUNCH 0
#endif

#ifndef PMASK
#define PMASK 0xFFFFFFFFu
#endif
#define PEN(k) ((PMASK >> (k)) & 1u)
#define LAS __attribute__((address_space(3)))
typedef unsigned short bf16_t;
typedef short bf16x8 __attribute__((ext_vector_type(8)));
typedef float f32x2 __attribute__((ext_vector_type(2)));
typedef float f32x4 __attribute__((ext_vector_type(4)));
typedef float f32x16 __attribute__((ext_vector_type(16)));
typedef unsigned u32x4 __attribute__((ext_vector_type(4)));
typedef unsigned u32x2 __attribute__((ext_vector_type(2)));

constexpr int T = 65536, D = 1024, SEQ = 8192, INC = 2816, FF = 2816, NL = 2;
constexpr float EPS = 1e-6f;
#ifndef PROBE_MIX
#define PROBE_MIX 0
#endif
#if PROBE_MIX
constexpr int NSUB = 24;
__device__ __constant__ const int SPSEQ[NSUB] = {0, 1, 2, 3, 4, 5, 1, 2, 3, 4, 5, 6, 7, 8, 9, 10, 11, 12, 13, 14, 15, 16, 17, 18};
#else
constexpr int NSUB = 18;
__device__ __constant__ const int SPSEQ[NSUB] = {0, 1, 2, 3, 4, 6, 7, 8, 9, 10, 11, 12, 13, 14, 15, 16, 17, 18};
#endif
constexpr int NPH = 1 + NSUB * NL;

constexpr size_t MiB = (size_t)1 << 20;
constexpr size_t OW_IN = 0, OW_GATE = OW_IN + (size_t)INC * D * 2, OW_UP = OW_GATE + (size_t)4096 * D * 2, OW_OUT = OW_UP + (size_t)4096 * 256 * 2,
                 OW_LRU = OW_OUT + (size_t)D * D * 2, OW_GLU = OW_LRU + (size_t)512 * 256 * 2, OW_Q = OW_GLU + (size_t)256 * 256 * 2, OW_KV = OW_Q + (size_t)D * D * 2,
                 OW_O = OW_KV + (size_t)2048 * D * 2, OW_GU = OW_O + (size_t)D * D * 2, OW_DOWN = OW_GU + (size_t)2 * FF * D * 2, OW_END = OW_DOWN + (size_t)D * FF * 2;
constexpr size_t WL_STRIDE = 43 * MiB;
static_assert(OW_END <= WL_STRIDE, "weights");
constexpr size_t WS_W = 0;
constexpr size_t WS_SMALL = 88 * MiB;
constexpr size_t SM_COS = WS_SMALL, SM_SIN = SM_COS + MiB, SM_S5P = SM_SIN + MiB, SM_BB = SM_S5P + 64 * 1024, SM_CM = SM_BB + 256 * 1024,
                 SM_MN = SM_CM + 128 * 1024, SM_KM = SM_MN + 8 * MiB, SM_VT = SM_KM + 4 * MiB, SM_SLOC = SM_VT + 4 * MiB, SM_DTOT = SM_SLOC + 16 * MiB,
                 SM_S5L = SM_DTOT + 256 * 1024, SM_LL = SM_S5L + MiB, SM_LB = SM_LL + MiB, SM_END = SM_LB + 4096;
static_assert(SM_END <= 128 * MiB, "small");
constexpr size_t WS_H = 128 * MiB, WS_Z = 256 * MiB, WS_Q = 608 * MiB, WS_X = 736 * MiB, WS_P = 768 * MiB, WS_END = 896 * MiB;
constexpr size_t WS_CTL = 126 * MiB, WS_XB = WS_END;
static_assert(SM_END <= WS_CTL, "ctl");
constexpr size_t WS_LG = WS_Q, WS_ACT5 = WS_Q + 64 * MiB;

constexpr int LDS_BYTES = 140 * 1024;
constexpr int GL_QD = 0, GL_KI = 4608, GL_KT = 9216, GL_VT = 14336, GL_ST = 19456, GL_BE = 28672, GL_BYTES = 28928;
constexpr int S5_OFF = 4 * GL_BYTES, S5_BYTES = 1024 + 4352;
static_assert(S5_OFF + 4 * S5_BYTES <= LDS_BYTES, "lds");

__device__ __forceinline__ float bf2f(unsigned b) { return __uint_as_float(b << 16); }
__device__ __forceinline__ float bflo(unsigned w) { return __uint_as_float(w << 16); }
__device__ __forceinline__ float bfhi(unsigned w) { return __uint_as_float(w & 0xffff0000u); }
__device__ __forceinline__ unsigned pk2(float lo, float hi) { unsigned r; asm("s_nop 1\n\tv_cvt_pk_bf16_f32 %0, %1, %2" : "=v"(r) : "v"(lo), "v"(hi)); return r; }
__device__ __forceinline__ bf16_t f2bf(float f) { return (bf16_t)(pk2(f, 0.f) & 0xffffu); }
__device__ __forceinline__ float sigm(float x) { return __builtin_amdgcn_rcpf(1.f + __expf(-x)); }
__device__ __forceinline__ float siluf(float x) { return x * sigm(x); }
__device__ __forceinline__ float gelu_t(float x) { const float u = 0.7978845608028654f * (x + 0.044715f * x * x * x); const float th = 1.f - 2.f * __builtin_amdgcn_rcpf(1.f + __expf(2.f * u)); return 0.5f * x * (1.f + th); }
__device__ __forceinline__ float wave_sum(float v) {
#pragma unroll
    for (int o = 1; o < 64; o <<= 1) v += __shfl_xor(v, o);
    return v;
}
__device__ __forceinline__ float wave_max(float v) {
#pragma unroll
    for (int o = 1; o < 64; o <<= 1) v = fmaxf(v, __shfl_xor(v, o));
    return v;
}
#define ENC(md) (100.f * (floorf(log2f(fmaxf((md), 1e-9f))) + 40.f))
#define LDS_FENCE() asm volatile("s_waitcnt lgkmcnt(0)" ::: "memory")
__device__ __forceinline__ void sincos_acc(double x, float& s, float& c) {
    const double q = rint(x * 0.63661977236758134308);
    double r = fma(-q, 1.57079632679489655800, x); r = fma(-q, 6.12323399573676603587e-17, r);
    const double r2 = r * r;
    double sp = -1.0 / 1307674368000.0; sp = sp * r2 + 1.0 / 6227020800.0; sp = sp * r2 - 1.0 / 39916800.0; sp = sp * r2 + 1.0 / 362880.0; sp = sp * r2 - 1.0 / 5040.0; sp = sp * r2 + 1.0 / 120.0; sp = sp * r2 - 1.0 / 6.0; sp = sp * r2 * r + r;
    double cp = 1.0 / 20922789888000.0; cp = cp * r2 - 1.0 / 87178291200.0; cp = cp * r2 + 1.0 / 479001600.0; cp = cp * r2 - 1.0 / 3628800.0; cp = cp * r2 + 1.0 / 40320.0; cp = cp * r2 - 1.0 / 720.0; cp = cp * r2 + 1.0 / 24.0; cp = cp * r2 - 0.5; cp = cp * r2 + 1.0;
    const int qi = ((int)(long long)q) & 3;
    const double ss = (qi & 1) ? cp : sp, cc = (qi & 1) ? sp : cp;
    s = (float)((qi & 2) ? -ss : ss); c = (float)(((qi + 1) & 2) ? -cc : cc);
}

namespace pg8 {
constexpr int BM = 256, BK = 64, HALF = 128, HTB = HALF * BK * 2, STAGE_BYTES = 8 * HTB, NXCD = 8, WGM = 8;
__host__ __device__ __forceinline__ int lds_byte(int r, int c) { const int st = (r >> 4) * 2 + (c >> 5), rr = r & 15, cc = c & 31, ob = rr * 64 + cc * 2; return st * 1024 + (ob ^ (((ob >> 9) & 1) << 5)); }
__host__ __device__ __forceinline__ void stage_rc(int b, int& R, int& C) { const int st = b / 1024, sb = b % 1024, swz = sb ^ (((sb >> 9) & 1) << 5); R = (st >> 1) * 16 + swz / 64; C = (st & 1) * 32 + (swz % 64) / 2; }
__host__ __device__ __forceinline__ int perm32(int rho) { const int n = rho >> 4, i = rho & 15; return 8 * (i >> 2) + 4 * n + (i & 3); }
struct Unit { int pm, pn; };
template <int M_, int N_, int K_, int LDA_, int LDB_, int APD_ = 1, int APM_ = 0, long BPS_ = -1, int BPD_ = 1, long BPM_ = 0>
struct GS { static constexpr int M = M_, N = N_, K = K_, lda = LDA_, ldb = LDB_, a_pn_div = APD_, a_pn_mul = APM_, b_pm_div = BPD_; static constexpr long b_pn_stride = BPS_ < 0 ? 256L * LDB_ : BPS_, b_pm_mul = BPM_; };
constexpr int GRID = 256;
template <class G_> struct StaticOrder {
    static constexpr int nM = G_::M / BM, nN = G_::N / BM, nwg = nM * nN, G = GRID;
    int c;
    __device__ __forceinline__ bool next(int i, Unit& u) const {
        const int L = i * G + c; if (L >= nwg) return false;
        int wgid = L; { constexpr int q = nwg / NXCD, r = nwg % NXCD; const int xcd = wgid % NXCD, off = wgid / NXCD; wgid = (xcd < r ? xcd * (q + 1) : r * (q + 1) + (xcd - r) * q) + off; }
        constexpr int nig = WGM * nN; const int gid = wgid / nig, fm = gid * WGM, gsz = (nM - fm) < WGM ? (nM - fm) : WGM;
        u.pm = fm + ((wgid % nig) % gsz); u.pn = (wgid % nig) / gsz; return true;
    }
};

template <int MODE  , int ldc, int ldm = 0> struct EpiBf16 {
    static constexpr bool PERM = true;
    bf16_t* O; const float* bias; const bf16_t* mul;
    __device__ __forceinline__ void operator()(const f32x4 (&acc)[2][2][4][2], const Unit& u, int wr, int wc, int fr, int fq) const {
        const int row0 = u.pm * BM + wr * 64 + fr, col0 = u.pn * BM + wc * 32 + 8 * fq;
        f32x4 bv[2][2];
#pragma unroll
        for (int bj = 0; bj < 2; ++bj)
#pragma unroll
            for (int n = 0; n < 2; ++n) bv[bj][n] = (MODE == 1 || MODE == 2) ? *(const f32x4*)(bias + col0 + bj * HALF + 4 * n) : (f32x4){0.f, 0.f, 0.f, 0.f};
#pragma unroll
        for (int ai = 0; ai < 2; ++ai)
#pragma unroll
            for (int m = 0; m < 4; ++m) {
                const size_t row = (size_t)(row0 + ai * HALF + m * 16);
                bf16_t* rowp = O + row * ldc + col0;
#pragma unroll
                for (int bj = 0; bj < 2; ++bj) {
                    f32x4 v0 = acc[ai][bj][m][0], v1 = acc[ai][bj][m][1];
                    if (MODE == 3) { v0 = v0 * 0.0625f; v1 = v1 * 0.0625f; }
                    else if (MODE != 0) {
                        v0 = v0 + bv[bj][0]; v1 = v1 + bv[bj][1];
#pragma unroll
                        for (int j = 0; j < 4; ++j) { v0[j] = sigm(v0[j]); v1[j] = sigm(v1[j]); }
                        if (MODE == 2) { const u32x4 mw = *(const u32x4*)(mul + row * ldm + col0 + bj * HALF);
                            v0[0] *= bflo(mw.x); v0[1] *= bfhi(mw.x); v0[2] *= bflo(mw.y); v0[3] *= bfhi(mw.y); v1[0] *= bflo(mw.z); v1[1] *= bfhi(mw.z); v1[2] *= bflo(mw.w); v1[3] *= bfhi(mw.w); }
                    }
                    u32x4 w; w.x = pk2(v0[0], v0[1]); w.y = pk2(v0[2], v0[3]); w.z = pk2(v1[0], v1[1]); w.w = pk2(v1[2], v1[3]);
                    *(u32x4*)(rowp + bj * HALF) = w;
                }
            }
    }
};
template <int ldc> struct EpiF32 {
    static constexpr bool PERM = false;
    float* C; float scale;
    __device__ __forceinline__ void operator()(const f32x4 (&acc)[2][2][4][2], const Unit& u, int wr, int wc, int fr, int fq) const {
        const int row0 = u.pm * BM + wr * 64 + fr, col0 = u.pn * BM + wc * 32 + 4 * fq;
#pragma unroll
        for (int ai = 0; ai < 2; ++ai)
#pragma unroll
            for (int m = 0; m < 4; ++m) { float* rowp = C + (size_t)(row0 + ai * HALF + m * 16) * ldc + col0;
#pragma unroll
                for (int bj = 0; bj < 2; ++bj)
#pragma unroll
                    for (int n = 0; n < 2; ++n) *(f32x4*)(rowp + bj * HALF + n * 16) = acc[ai][bj][m][n] * scale; }
    }
};
struct EpiMix {
    static constexpr bool PERM = false;
    bf16_t* O; const float* bias; const bf16_t* up;
    __device__ __forceinline__ void operator()(const f32x4 (&acc)[2][2][4][2], const Unit& u, int wr, int wc, int fr, int fq) const {
        const int row0 = u.pm * BM + wr * 64 + fr, c0 = u.pn * 64 + wc * 16 + 4 * fq;
        f32x4 bv[2][2];
#pragma unroll
        for (int bj = 0; bj < 2; ++bj)
#pragma unroll
            for (int n = 0; n < 2; ++n) bv[bj][n] = *(const f32x4*)(bias + (2 * bj + n) * 1024 + c0);
#pragma unroll
        for (int ai = 0; ai < 2; ++ai)
#pragma unroll
            for (int m = 0; m < 4; ++m) {
                const size_t row = (size_t)(row0 + ai * HALF + m * 16);
                f32x4 s = (f32x4){0.f, 0.f, 0.f, 0.f};
#pragma unroll
                for (int bj = 0; bj < 2; ++bj)
#pragma unroll
                    for (int n = 0; n < 2; ++n) {
                        const u32x2 uw = *(const u32x2*)(up + row * 4096 + (2 * bj + n) * 1024 + c0);
                        const f32x4 g = acc[ai][bj][m][n] + bv[bj][n];
                        s[0] += sigm(g[0]) * bflo(uw.x); s[1] += sigm(g[1]) * bfhi(uw.x); s[2] += sigm(g[2]) * bflo(uw.y); s[3] += sigm(g[3]) * bfhi(uw.y);
                    }
                u32x2 w; w.x = pk2(s[0], s[1]); w.y = pk2(s[2], s[3]);
                *(u32x2*)(O + row * 1024 + c0) = w;
            }
    }
};
struct EpiGU {
    static constexpr bool PERM = false;
    bf16_t* O;
    __device__ __forceinline__ void operator()(const f32x4 (&acc)[2][2][4][2], const Unit& u, int wr, int wc, int fr, int fq) const {
        const int row0 = u.pm * BM + wr * 64 + fr, c0 = u.pn * 128 + wc * 16 + 4 * fq;
#pragma unroll
        for (int ai = 0; ai < 2; ++ai)
#pragma unroll
            for (int m = 0; m < 4; ++m) {
                const size_t row = (size_t)(row0 + ai * HALF + m * 16);
#pragma unroll
                for (int bj = 0; bj < 2; ++bj) {
                    const f32x4 g = acc[ai][bj][m][0], p = acc[ai][bj][m][1];
                    u32x2 w; w.x = pk2(siluf(g[0]) * p[0], siluf(g[1]) * p[1]); w.y = pk2(siluf(g[2]) * p[2], siluf(g[3]) * p[3]);
                    *(u32x2*)(O + row * FF + c0 + 64 * bj) = w;
                }
            }
    }
};

template <class g, class Epi>
__device__ __forceinline__ void gemm_phase(int tid, LAS unsigned char* lds, const bf16_t* gA, const bf16_t* gBt, int cblk, const Epi& E) {
    StaticOrder<g> S; S.c = cblk;
    const int wid = __builtin_amdgcn_readfirstlane(tid >> 6), lane = tid & 63, wr = wid >> 2, wc = wid & 3, fr = lane & 15, fq = lane >> 4;
    constexpr int K = g::K, nt = K / BK;
    unsigned voffA[2], voffB[2];
#pragma unroll
    for (int i = 0; i < 2; ++i) { int R, C; stage_rc(tid * 16 + i * 8192, R, C); const int Rb = Epi::PERM ? ((R & ~31) + perm32(R & 31)) : R;
        voffA[i] = (unsigned)(R * g::lda + C) * 2u; voffB[i] = (unsigned)(Rb * g::ldb + C) * 2u; }
    constexpr size_t kstep = (size_t)(BK * 2);
    constexpr size_t hstepA = (size_t)HALF * g::lda * 2, hstepB = (size_t)HALF * g::ldb * 2;
    const unsigned ldsw = (unsigned)wid * 1024u;
    const int aoff = lds_byte(wr * 64 + fr, fq * 8), boff = lds_byte(wc * 32 + fr, fq * 8);
#define PG8_SA(b, h) (((b) * 2 + (h)) * HTB)
#define PG8_SB(b, h) ((4 + (b) * 2 + (h)) * HTB)
#define PG8_STAGE(bufoff, gbase, voff) do { _Pragma("unroll") for (int _i = 0; _i < 2; ++_i) \
        __builtin_amdgcn_global_load_lds((const unsigned*)((const char*)(gbase) + (voff)[_i]), (LAS unsigned*)(lds + (bufoff) + ldsw + _i * 8192), 16, 0, 0); } while (0)
#define PG8_LDA(dst, b, h) do { _Pragma("unroll") for (int m = 0; m < 4; ++m) _Pragma("unroll") for (int k = 0; k < 2; ++k) dst[m][k] = *(const LAS bf16x8*)(lds + PG8_SA(b, h) + aoff + m * 2048 + k * 1024); } while (0)
#define PG8_LDB(dst, b, h) do { _Pragma("unroll") for (int n = 0; n < 2; ++n) _Pragma("unroll") for (int k = 0; k < 2; ++k) dst[n][k] = *(const LAS bf16x8*)(lds + PG8_SB(b, h) + boff + n * 2048 + k * 1024); } while (0)
#define PG8_MMA(ai, bj, At, Bt) do { __builtin_amdgcn_s_setprio(1); _Pragma("unroll") for (int m = 0; m < 4; ++m) _Pragma("unroll") for (int n = 0; n < 2; ++n) _Pragma("unroll") for (int k = 0; k < 2; ++k) \
        acc[ai][bj][m][n] = __builtin_amdgcn_mfma_f32_16x16x32_bf16(Bt[n][k], At[m][k], acc[ai][bj][m][n], 0, 0, 0); __builtin_amdgcn_s_setprio(0); } while (0)
#define PG8_WAIT_V(n) asm volatile("s_waitcnt vmcnt(" #n ")" ::: "memory")
#define PG8_WAIT_L(n) asm volatile("s_waitcnt lgkmcnt(" #n ")" ::: "memory")
#define PG8_BAR __builtin_amdgcn_s_barrier()
#define PG8_SCHED __builtin_amdgcn_sched_barrier(0)
#define PG8_ABASE(u) ((const char*)gA + ((size_t)(u).pm * BM * g::lda + (size_t)((u).pn / g::a_pn_div) * g::a_pn_mul) * 2)
#define PG8_BBASE(u) ((const char*)gBt + ((size_t)(u).pn * g::b_pn_stride + (size_t)((u).pm / g::b_pm_div) * g::b_pm_mul) * 2)
    Unit cur, nxt; int ui = 0;
    if (!S.next(0, cur)) return;
    f32x4 acc[2][2][4][2];
#pragma unroll
    for (int a = 0; a < 2; ++a)
#pragma unroll
        for (int b = 0; b < 2; ++b)
#pragma unroll
            for (int m = 0; m < 4; ++m)
#pragma unroll
                for (int n = 0; n < 2; ++n) acc[a][b][m][n] = (f32x4){0.f, 0.f, 0.f, 0.f};
    bf16x8 At[4][2], B0[2][2], B1[2][2];
    const char* cA = PG8_ABASE(cur); const char* cB = PG8_BBASE(cur);
    PG8_STAGE(PG8_SB(0, 0), cB, voffB); PG8_STAGE(PG8_SA(0, 0), cA, voffA); PG8_STAGE(PG8_SB(0, 1), cB + hstepB, voffB); PG8_STAGE(PG8_SA(0, 1), cA + hstepA, voffA);
    if (wr == 1) PG8_BAR;
    PG8_WAIT_V(4); PG8_BAR;
    PG8_STAGE(PG8_SB(1, 0), cB + kstep, voffB); PG8_STAGE(PG8_SA(1, 0), cA + kstep, voffA); PG8_STAGE(PG8_SB(1, 1), cB + hstepB + kstep, voffB);
    PG8_WAIT_V(6); PG8_BAR;
    for (;;) {
        const bool has_next = S.next(ui + 1, nxt);
        const char* nA = has_next ? PG8_ABASE(nxt) : cA; const char* nB = has_next ? PG8_BBASE(nxt) : cB;
#pragma unroll 1
        for (int t = 0; t < nt; t += 2) {
            const bool last = (t == nt - 2);
            const char* a1 = cA + (size_t)(t + 1) * kstep;
            const char* a2 = last ? nA : cA + (size_t)(t + 2) * kstep; const char* b2 = last ? nB : cB + (size_t)(t + 2) * kstep;
            const char* a3 = a2 + kstep; const char* b3 = b2 + kstep;
            PG8_LDB(B0, 0, 0); PG8_SCHED; PG8_LDA(At, 0, 0); PG8_STAGE(PG8_SA(1, 1), a1 + hstepA, voffA);
            PG8_WAIT_L(8); PG8_BAR; PG8_WAIT_L(0); PG8_MMA(0, 0, At, B0); PG8_BAR; PG8_SCHED;
            PG8_LDB(B1, 0, 1); PG8_STAGE(PG8_SB(0, 0), b2, voffB);
            PG8_BAR; PG8_WAIT_L(0); PG8_MMA(0, 1, At, B1); PG8_BAR;
            PG8_LDA(At, 0, 1); PG8_STAGE(PG8_SA(0, 0), a2, voffA);
            PG8_BAR; PG8_WAIT_L(0); PG8_MMA(1, 0, At, B0); PG8_BAR; PG8_SCHED;
            PG8_STAGE(PG8_SB(0, 1), b2 + hstepB, voffB);
            PG8_WAIT_V(6); PG8_BAR; PG8_MMA(1, 1, At, B1); PG8_BAR;
            PG8_LDB(B0, 1, 0); PG8_SCHED; PG8_LDA(At, 1, 0); PG8_STAGE(PG8_SA(0, 1), a2 + hstepA, voffA);
            PG8_WAIT_L(8); PG8_BAR; PG8_WAIT_L(0); PG8_MMA(0, 0, At, B0); PG8_BAR; PG8_SCHED;
            PG8_LDB(B1, 1, 1); PG8_STAGE(PG8_SB(1, 0), b3, voffB);
            PG8_BAR; PG8_WAIT_L(0); PG8_MMA(0, 1, At, B1); PG8_BAR;
            PG8_LDA(At, 1, 1); PG8_STAGE(PG8_SA(1, 0), a3, voffA);
            PG8_BAR; PG8_WAIT_L(0); PG8_MMA(1, 0, At, B0); PG8_BAR; PG8_SCHED;
            PG8_STAGE(PG8_SB(1, 1), b3 + hstepB, voffB);
            PG8_WAIT_V(6); PG8_BAR; PG8_MMA(1, 1, At, B1); PG8_BAR;
        }
        E(acc, cur, wr, wc, fr, fq);
        if (!has_next) break;
#pragma unroll
        for (int a = 0; a < 2; ++a)
#pragma unroll
            for (int b = 0; b < 2; ++b)
#pragma unroll
                for (int m = 0; m < 4; ++m)
#pragma unroll
                    for (int n = 0; n < 2; ++n) acc[a][b][m][n] = (f32x4){0.f, 0.f, 0.f, 0.f};
        cur = nxt; cA = nA; cB = nB; ++ui;
    }
    PG8_WAIT_V(0);
    if (wr == 0) PG8_BAR;
    PG8_BAR;
#undef PG8_SA
#undef PG8_SB
#undef PG8_STAGE
#undef PG8_LDA
#undef PG8_LDB
#undef PG8_MMA
#undef PG8_WAIT_V
#undef PG8_WAIT_L
#undef PG8_BAR
#undef PG8_SCHED
#undef PG8_ABASE
#undef PG8_BBASE
}
}

struct Args { const float* in[39]; float* out; unsigned char* ws; int ph_lo, ph_hi; };
enum { I_X = 0, I_MEM, I_HGLB, I_NMIXPRE, I_NMIXPOST, I_WIN, I_WGATE, I_BGATE, I_HGNORM, I_RETNORM, I_CONVW, I_CONVB, I_WA, I_BA, I_WX, I_BX, I_LAM,
       I_S5LRE, I_S5LIM, I_S5BRE, I_S5BIM, I_S5CRE, I_S5CIM, I_S5D, I_S5LDT, I_GLUW, I_GLUB, I_WUP, I_WOUT, I_NXAPRE, I_NXAPOST, I_NMEM, I_WQ, I_WKV, I_WO,
       I_NFFNPRE, I_NFFNPOST, I_WGU, I_WDOWN };

struct Ctx {
    LAS const unsigned long long* pt; unsigned char* ws;
    __device__ __forceinline__ const float* in(int k) const { const unsigned long long v = pt[k]; const unsigned lo = __builtin_amdgcn_readfirstlane((unsigned)v), hi = __builtin_amdgcn_readfirstlane((unsigned)(v >> 32)); return (const float*)(((unsigned long long)hi << 32) | lo); }
};
__device__ __forceinline__ int src_col(int mode, int n) {
    if (mode == 0) return n;
    const int pn = n >> 8, L = n & 255, bj = L >> 7, wc = (L >> 5) & 3, nn = (L >> 4) & 1, r = L & 15;
    if (mode == 1) return (2 * bj + nn) * 1024 + 64 * pn + 16 * wc + r;
    const int ff = 128 * pn + 64 * bj + 16 * wc + r; return nn ? FF + ff : ff;
}
__device__ __forceinline__ void transpose_item(const float* W, int ldw, int K, int N, bf16_t* WT, int mode, LAS float* scr, int it, int lane) {
    const int nblk = N / 32;
    const int kb = it / nblk, nb = it % nblk, k0 = 64 * kb, n0 = 32 * nb;
    const int sc = src_col(mode, n0 + (lane & 31));
#pragma unroll 8
    for (int i = 0; i < 32; ++i) { const int kk = 2 * i + (lane >> 5); scr[kk * 33 + (lane & 31)] = W[(size_t)(k0 + kk) * ldw + sc]; }
    LDS_FENCE();
    const int c = lane & 7;
#pragma unroll
    for (int j = 0; j < 4; ++j) { const int n = (lane >> 3) + 8 * j; const LAS float* s = scr + (8 * c) * 33 + n;
        u32x4 o; o.x = pk2(s[0 * 33], s[1 * 33]); o.y = pk2(s[2 * 33], s[3 * 33]); o.z = pk2(s[4 * 33], s[5 * 33]); o.w = pk2(s[6 * 33], s[7 * 33]);
        *(u32x4*)(WT + (size_t)(n0 + n) * K + k0 + 8 * c) = o; }
    LDS_FENCE();
}
template <bool SRC16, bool DST16>
__device__ __forceinline__ void addnorm_rows(const void* xsrc_, void* xdst_, const bf16_t* y, const float* gpost, const float* gpre, bf16_t* h, int nrows, int gw, int NGW, int lane) {
    for (int row0 = gw; row0 < nrows; row0 += 2 * NGW) {
        const int nr = (row0 + NGW < nrows) ? 2 : 1;
        f32x4 v[2][4]; u32x2 yw[2][4];
#pragma unroll
        for (int u = 0; u < 2; ++u) if (u < nr) { const size_t row = (size_t)(row0 + u * NGW);
            if (SRC16) { const u32x2* xr = (const u32x2*)((const bf16_t*)xsrc_ + row * D) + lane;
#pragma unroll
                for (int j = 0; j < 4; ++j) { const u32x2 w = xr[64 * j]; v[u][j] = (f32x4){bflo(w.x), bfhi(w.x), bflo(w.y), bfhi(w.y)}; } }
            else { const f32x4* xr = (const f32x4*)((const float*)xsrc_ + row * D) + lane;
#pragma unroll
                for (int j = 0; j < 4; ++j) v[u][j] = xr[64 * j]; }
            if (y) { const u32x2* yr = (const u32x2*)(y + row * D) + lane;
#pragma unroll
                for (int j = 0; j < 4; ++j) yw[u][j] = yr[64 * j]; } }
#pragma unroll
        for (int u = 0; u < 2; ++u) if (u < nr) { const size_t row = (size_t)(row0 + u * NGW);
            if (y) {
                f32x4 yv[4]; float ss = 0.f;
#pragma unroll
                for (int j = 0; j < 4; ++j) { const u32x2 w = yw[u][j]; yv[j] = (f32x4){bflo(w.x), bfhi(w.x), bflo(w.y), bfhi(w.y)}; ss += yv[j][0] * yv[j][0] + yv[j][1] * yv[j][1] + yv[j][2] * yv[j][2] + yv[j][3] * yv[j][3]; }
                ss = wave_sum(ss); const float rs = rsqrtf(ss * (1.f / D) + EPS);
#pragma unroll
                for (int j = 0; j < 4; ++j) { const f32x4 g = ((const f32x4*)gpost)[64 * j + lane]; v[u][j] = v[u][j] + yv[j] * rs * g; }
            }
            if (xdst_) {
                if (DST16) { u32x2* xw = (u32x2*)((bf16_t*)xdst_ + row * D) + lane;
#pragma unroll
                    for (int j = 0; j < 4; ++j) { u32x2 w; w.x = pk2(v[u][j][0], v[u][j][1]); w.y = pk2(v[u][j][2], v[u][j][3]); xw[64 * j] = w; } }
                else { f32x4* xw = (f32x4*)((float*)xdst_ + row * D) + lane;
#pragma unroll
                    for (int j = 0; j < 4; ++j) xw[64 * j] = v[u][j]; } }
            if (h) {
                float ss = 0.f;
#pragma unroll
                for (int j = 0; j < 4; ++j) ss += v[u][j][0] * v[u][j][0] + v[u][j][1] * v[u][j][1] + v[u][j][2] * v[u][j][2] + v[u][j][3] * v[u][j][3];
                ss = wave_sum(ss); const float rs = rsqrtf(ss * (1.f / D) + EPS);
                u32x2* hw = (u32x2*)(h + row * D) + lane;
#pragma unroll
                for (int j = 0; j < 4; ++j) { const f32x4 g = ((const f32x4*)gpre)[64 * j + lane]; const f32x4 o = v[u][j] * rs * g; u32x2 w; w.x = pk2(o[0], o[1]); w.y = pk2(o[2], o[3]); hw[64 * j] = w; }
            } }
    }
}

template <bool OUT>
__device__ __forceinline__ void gla_item(const Ctx& a, int layer, int item, LAS unsigned char* wl, int lane) {
    unsigned char* ws = a.ws;
    const int hh = item & 3, mx = (item >> 2) & 1, sc = (item >> 3) & 15, b = item >> 7;
    const int r = lane & 31, h = lane >> 5;
    const bf16_t* Z = (const bf16_t*)(ws + WS_Z);
    bf16_t* YC = (bf16_t*)(ws + WS_P);
    float* SLOC = (float*)(ws + SM_SLOC); float* DTOT = (float*)(ws + SM_DTOT);
    const float* COS = (const float*)(ws + SM_COS); const float* SIN = (const float*)(ws + SM_SIN);
    LAS bf16_t* QD = (LAS bf16_t*)(wl + GL_QD); LAS bf16_t* KI = (LAS bf16_t*)(wl + GL_KI); LAS bf16_t* KT = (LAS bf16_t*)(wl + GL_KT);
    LAS bf16_t* VT = (LAS bf16_t*)(wl + GL_VT); LAS bf16_t* ST = (LAS bf16_t*)(wl + GL_ST); LAS float* BE = (LAS float*)(wl + GL_BE);
    LAS bf16_t* PM = KI;
    const int cq = (mx ? 1024 : 0) + 64 * hh + lane;
    float lb = 0.f, lgam = 0.f;
    if (mx == 0) { if (layer > 0) { const float b0 = a.in(I_HGLB)[64 * hh + lane], b1 = a.in(I_HGLB)[256 + 64 * hh + lane]; const float mxb = fmaxf(b0, b1); const float e0 = __expf(b0 - mxb), e1 = __expf(b1 - mxb); lb = e1 / (e0 + e1); } }
    else lgam = 1.f - exp2f(-5.f - (float)hh);
    f32x16 S[2][2];
#pragma unroll
    for (int mt = 0; mt < 2; ++mt)
#pragma unroll
        for (int nt = 0; nt < 2; ++nt)
#pragma unroll
            for (int e = 0; e < 16; ++e) S[mt][nt][e] = 0.f;
    if (OUT) {
        { const float* sl = SLOC + (size_t)item * 4096 + (4 * h) * 64 + r;
#pragma unroll
          for (int mt = 0; mt < 2; ++mt)
#pragma unroll
              for (int nt = 0; nt < 2; ++nt)
#pragma unroll
                  for (int e = 0; e < 16; ++e) S[mt][nt][e] = sl[(32 * mt + (e & 3) + 8 * (e >> 2)) * 64 + 32 * nt]; }
#pragma unroll
        for (int mt = 0; mt < 2; ++mt)
#pragma unroll
            for (int nt = 0; nt < 2; ++nt)
#pragma unroll
                for (int g4 = 0; g4 < 4; ++g4) { u32x2 w; w.x = pk2(S[mt][nt][4 * g4], S[mt][nt][4 * g4 + 1]); w.y = pk2(S[mt][nt][4 * g4 + 2], S[mt][nt][4 * g4 + 3]);
                    *(LAS u32x2*)(ST + (32 * nt + r) * 72 + 32 * mt + 8 * g4 + 4 * h) = w; }
    }
    float dprod = 1.f;
    const size_t tok0 = (size_t)b * SEQ + (size_t)sc * 512;
    const float* gn = a.in(mx ? I_RETNORM : I_HGNORM) + layer * 256 + 64 * hh;
    const int cq0 = (mx ? 1024 : 0) + 64 * hh;
    LAS bf16_t* VS = KT;
    const int ptok = lane >> 3, pc8 = (lane & 7) * 8;
    u32x4 pq[4], pf[4], pv[4]; float pc0 = 1.f, ps0 = 0.f, cd = 1.f, sd = 0.f;
    if (mx) { cd = COS[32 + (lane >> 1)]; sd = SIN[32 + (lane >> 1)]; }
#define GLA_PREFETCH(chn) do { const bf16_t* zp = Z + (tok0 + (size_t)(chn) * 32 + ptok) * INC + cq0 + pc8; \
        _Pragma("unroll") for (int i = 0; i < 4; ++i) { const bf16_t* zz = zp + (size_t)(8 * i) * INC; if (OUT) pq[i] = *(const u32x4*)zz; pf[i] = *(const u32x4*)(zz + 256); pv[i] = *(const u32x4*)(zz + 512); } \
        if (mx) { pc0 = COS[(sc * 512 + (chn) * 32) * 32 + (lane >> 1)]; ps0 = SIN[(sc * 512 + (chn) * 32) * 32 + (lane >> 1)]; } } while (0)
    GLA_PREFETCH(0);
#pragma unroll 1
    for (int ch = 0; ch < 16; ++ch) {
        const bf16_t* zr = Z + (tok0 + ch * 32) * INC;
#pragma unroll
        for (int i = 0; i < 4; ++i) { const int tk = ptok + 8 * i; if (OUT) *(LAS u32x4*)(QD + tk * 72 + pc8) = pq[i]; *(LAS u32x4*)(KI + tk * 72 + pc8) = pf[i]; *(LAS u32x4*)(VS + tk * 64 + pc8) = pv[i]; }
        float cs = pc0, sn = ps0;
        LDS_FENCE();
        if (ch + 1 < 16) GLA_PREFETCH(ch + 1);
        u32x2 gpre[2][4];
        if (OUT) { const bf16_t* zt = zr + (size_t)r * INC + cq0 + 768;
#pragma unroll
            for (int mt = 0; mt < 2; ++mt)
#pragma unroll
                for (int g4 = 0; g4 < 4; ++g4) gpre[mt][g4] = *(const u32x2*)(zt + 32 * mt + 8 * g4 + 4 * h); }
#pragma unroll
        for (int t4 = 0; t4 < 32; t4 += 4) { u32x2 w; w.x = (unsigned)VS[t4 * 64 + lane] | ((unsigned)VS[(t4 + 1) * 64 + lane] << 16); w.y = (unsigned)VS[(t4 + 2) * 64 + lane] | ((unsigned)VS[(t4 + 3) * 64 + lane] << 16);
            *(LAS u32x2*)(VT + lane * 40 + t4) = w; }
        LDS_FENCE();
        float ec = 1.f;
#pragma unroll 2
        for (int t4 = 0; t4 < 32; t4 += 4) {
            float kiv[4];
#pragma unroll
            for (int u = 0; u < 4; ++u) {
                const int t = t4 + u;
                float qv = OUT ? bf2f(QD[t * 72 + lane]) : 0.f; float fv = bf2f(KI[t * 72 + lane]);
                float kk, lf;
                if (mx == 0) { const float f = lb + (1.f - lb) * sigm(fv); lf = f; kk = 1.f - f; qv = siluf(qv); }
                else {
                    const float qp = __shfl_xor(qv, 1), kp = __shfl_xor(fv, 1);
                    const float sg = (lane & 1) ? sn : -sn;
                    qv = qv * cs + qp * sg; kk = (fv * cs + kp * sg) * 0.125f; lf = lgam;
                    const float c2 = cs * cd - sn * sd; sn = sn * cd + cs * sd; cs = c2;
                }
                ec *= lf;
                const float e = ec, ei = __builtin_amdgcn_rcpf(ec);
                if (OUT) QD[t * 72 + lane] = f2bf(qv * e);
                const float ki = kk * ei;
                KI[t * 72 + lane] = f2bf(ki); kiv[u] = ki;
            }
            u32x2 w; w.x = pk2(kiv[0], kiv[1]); w.y = pk2(kiv[2], kiv[3]); *(LAS u32x2*)(KT + lane * 40 + t4) = w;
        }
        BE[lane] = ec; dprod *= ec;
        LDS_FENCE();
        if (OUT) {
            f32x16 sct;
#pragma unroll
            for (int e = 0; e < 16; ++e) sct[e] = 0.f;
#pragma unroll
            for (int ks = 0; ks < 4; ++ks) { const bf16x8 av = *(const LAS bf16x8*)(KI + r * 72 + 16 * ks + 8 * h), bq = *(const LAS bf16x8*)(QD + r * 72 + 16 * ks + 8 * h);
                sct = __builtin_amdgcn_mfma_f32_32x32x16_bf16(av, bq, sct, 0, 0, 0); }
            LDS_FENCE();
#pragma unroll
            for (int g4 = 0; g4 < 4; ++g4) { const int s0 = 8 * g4 + 4 * h; float p[4];
#pragma unroll
                for (int i = 0; i < 4; ++i) p[i] = (s0 + i <= r) ? sct[4 * g4 + i] : 0.f;
                u32x2 w; w.x = pk2(p[0], p[1]); w.y = pk2(p[2], p[3]); *(LAS u32x2*)(PM + r * 40 + s0) = w; }
            LDS_FENCE();
            f32x16 oT[2];
#pragma unroll
            for (int mt = 0; mt < 2; ++mt) {
                __builtin_amdgcn_sched_barrier(0);
#pragma unroll
                for (int e = 0; e < 16; ++e) oT[mt][e] = 0.f;
#pragma unroll
                for (int ks = 0; ks < 2; ++ks) { const bf16x8 av = *(const LAS bf16x8*)(VT + (32 * mt + r) * 40 + 16 * ks + 8 * h), bp = *(const LAS bf16x8*)(PM + r * 40 + 16 * ks + 8 * h);
                    oT[mt] = __builtin_amdgcn_mfma_f32_32x32x16_bf16(av, bp, oT[mt], 0, 0, 0); }
#pragma unroll
                for (int ks = 0; ks < 4; ++ks) { const bf16x8 av = *(const LAS bf16x8*)(ST + (32 * mt + r) * 72 + 16 * ks + 8 * h), bq = *(const LAS bf16x8*)(QD + r * 72 + 16 * ks + 8 * h);
                    oT[mt] = __builtin_amdgcn_mfma_f32_32x32x16_bf16(av, bq, oT[mt], 0, 0, 0); }
            }
            __builtin_amdgcn_sched_barrier(0);
            float ss = 0.f;
#pragma unroll
            for (int mt = 0; mt < 2; ++mt)
#pragma unroll
                for (int e = 0; e < 16; ++e) ss += oT[mt][e] * oT[mt][e];
            ss += __shfl_xor(ss, 32);
            const float rs = rsqrtf(ss * (1.f / 64.f) + EPS);
            bf16_t* yo = YC + (tok0 + ch * 32 + r) * D + 256 * mx + 64 * hh;
#pragma unroll
            for (int mt = 0; mt < 2; ++mt)
#pragma unroll
                for (int g4 = 0; g4 < 4; ++g4) { const int dv0 = 32 * mt + 8 * g4 + 4 * h; const u32x2 gw = gpre[mt][g4]; const f32x4 nv = *(const f32x4*)(gn + dv0);
                    const float g0 = siluf(bflo(gw.x)), g1 = siluf(bfhi(gw.x)), g2 = siluf(bflo(gw.y)), g3 = siluf(bfhi(gw.y));
                    u32x2 w; w.x = pk2(oT[mt][4 * g4] * rs * nv[0] * g0, oT[mt][4 * g4 + 1] * rs * nv[1] * g1);
                    w.y = pk2(oT[mt][4 * g4 + 2] * rs * nv[2] * g2, oT[mt][4 * g4 + 3] * rs * nv[3] * g3);
                    *(u32x2*)(yo + dv0) = w; }
        }
        __builtin_amdgcn_sched_barrier(0);
#pragma unroll
        for (int mt = 0; mt < 2; ++mt)
#pragma unroll
            for (int nt = 0; nt < 2; ++nt) {
                __builtin_amdgcn_sched_barrier(0);
#pragma unroll
                for (int ks = 0; ks < 2; ++ks) { const bf16x8 av = *(const LAS bf16x8*)(KT + (32 * mt + r) * 40 + 16 * ks + 8 * h), bv = *(const LAS bf16x8*)(VT + (32 * nt + r) * 40 + 16 * ks + 8 * h);
                    S[mt][nt] = __builtin_amdgcn_mfma_f32_32x32x16_bf16(av, bv, S[mt][nt], 0, 0, 0); } }
        __builtin_amdgcn_sched_barrier(0);
#pragma unroll
        for (int mt = 0; mt < 2; ++mt)
#pragma unroll
            for (int g4 = 0; g4 < 4; ++g4) { const f32x4 be = *(const LAS f32x4*)(BE + 32 * mt + 8 * g4 + 4 * h);
#pragma unroll
                for (int i = 0; i < 4; ++i) { const float eb = be[i];
#pragma unroll
                    for (int nt = 0; nt < 2; ++nt) S[mt][nt][4 * g4 + i] *= eb; } }
        if (OUT) {
            LDS_FENCE();
#pragma unroll
            for (int mt = 0; mt < 2; ++mt)
#pragma unroll
                for (int nt = 0; nt < 2; ++nt)
#pragma unroll
                    for (int g4 = 0; g4 < 4; ++g4) { u32x2 w; w.x = pk2(S[mt][nt][4 * g4], S[mt][nt][4 * g4 + 1]); w.y = pk2(S[mt][nt][4 * g4 + 2], S[mt][nt][4 * g4 + 3]);
                        *(LAS u32x2*)(ST + (32 * nt + r) * 72 + 32 * mt + 8 * g4 + 4 * h) = w; }
        }
        LDS_FENCE();
    }
    if (!OUT) {
        float* sl = SLOC + (size_t)item * 4096;
#pragma unroll
        for (int mt = 0; mt < 2; ++mt)
#pragma unroll
            for (int nt = 0; nt < 2; ++nt)
#pragma unroll
                for (int e = 0; e < 16; ++e) sl[(32 * mt + (e & 3) + 8 * (e >> 2) + 4 * h) * 64 + 32 * nt + r] = S[mt][nt][e];
        DTOT[(size_t)item * 64 + lane] = dprod;
    }
}

template <bool OUT>
__device__ __forceinline__ void s5_item(const Ctx& a, int layer, int item, LAS unsigned char* wl, int lane) {
    unsigned char* ws = a.ws;
    const int g = item & 15, sc = (item >> 4) & 15, b = item >> 8;
    const bf16_t* Z = (const bf16_t*)(ws + WS_Z);
    bf16_t* ACT = (bf16_t*)(ws + WS_ACT5);
    const float* P = (const float*)(ws + SM_S5P) + ((size_t)(layer * 16 + g) * 64 + lane) * 4;
    const float lbr = P[0], lbi = P[1], lsr = P[2], lsi = P[3];
    const float* bbp = (const float*)(ws + SM_BB) + ((size_t)(layer * 16 + g) * 64 + lane) * 32;
    float bbr[16], bbi[16];
#pragma unroll
    for (int p = 0; p < 16; p += 4) { const f32x4 x = *(const f32x4*)(bbp + p), y = *(const f32x4*)(bbp + 16 + p);
#pragma unroll
        for (int i = 0; i < 4; ++i) { bbr[p + i] = x[i]; bbi[p + i] = y[i]; } }
    float* S5L = (float*)(ws + SM_S5L);
    float hr = 0.f, hi = 0.f;
    if (OUT) for (int j = 0; j < sc; ++j) { const f32x2 lc = *(const f32x2*)(S5L + ((size_t)((b * 16 + j) * 16 + g) * 64 + lane) * 2);
        const float nr = lsr * hr - lsi * hi + lc[0], ni = lsr * hi + lsi * hr + lc[1]; hr = nr; hi = ni; }
    LAS float* ul = (LAS float*)wl; LAS bf16_t* hb = (LAS bf16_t*)(wl + 1024);
    const int fr = lane & 15, fq = lane >> 4;
    bf16x8 cf[4]; float dval = 0.f;
    if (OUT) { const bf16_t* cm = (const bf16_t*)(ws + SM_CM) + ((size_t)(layer * 16 + g) * 16 + fr) * 128;
#pragma unroll
        for (int ks = 0; ks < 4; ++ks) cf[ks] = *(const bf16x8*)(cm + 32 * ks + 8 * fq);
        dval = a.in(I_S5D)[layer * 256 + 16 * g + fr]; }
    const size_t tok0 = (size_t)b * SEQ + (size_t)sc * 512;
    for (int sub = 0; sub < 32; ++sub) {
        { const int tk = lane >> 2, p0 = (lane & 3) * 4; const u32x2 w = *(const u32x2*)(Z + (tok0 + sub * 16 + tk) * INC + 2560 + 16 * g + p0);
          *(LAS f32x4*)(ul + tk * 16 + p0) = (f32x4){bflo(w.x), bfhi(w.x), bflo(w.y), bfhi(w.y)}; }
        LDS_FENCE();
#pragma unroll 4
        for (int t = 0; t < 16; ++t) {
            float br0 = 0.f, br1 = 0.f, bi0 = 0.f, bi1 = 0.f;
#pragma unroll
            for (int p = 0; p < 16; p += 4) { const f32x4 u = *(const LAS f32x4*)(ul + t * 16 + p);
                br0 += bbr[p] * u[0] + bbr[p + 2] * u[2]; br1 += bbr[p + 1] * u[1] + bbr[p + 3] * u[3];
                bi0 += bbi[p] * u[0] + bbi[p + 2] * u[2]; bi1 += bbi[p + 1] * u[1] + bbi[p + 3] * u[3]; }
            const float nr = lbr * hr - lbi * hi + (br0 + br1), ni = lbr * hi + lbi * hr + (bi0 + bi1); hr = nr; hi = ni;
            if (OUT) { hb[t * 136 + lane] = f2bf(hr); hb[t * 136 + 64 + lane] = f2bf(hi); }
        }
        if (OUT) {
            LDS_FENCE();
            f32x4 acc = (f32x4){0.f, 0.f, 0.f, 0.f};
#pragma unroll
            for (int ks = 0; ks < 4; ++ks) { const bf16x8 av = *(const LAS bf16x8*)(hb + fr * 136 + 32 * ks + 8 * fq); acc = __builtin_amdgcn_mfma_f32_16x16x32_bf16(av, cf[ks], acc, 0, 0, 0); }
#pragma unroll
            for (int e = 0; e < 4; ++e) { const int tk = fq * 4 + e; const float y = acc[e] + dval * ul[tk * 16 + fr];
                ACT[(tok0 + sub * 16 + tk) * 256 + 16 * g + fr] = f2bf(gelu_t(y)); }
        }
        LDS_FENCE();
    }
    if (!OUT) *(f32x2*)(S5L + ((size_t)((b * 16 + sc) * 16 + g) * 64 + lane) * 2) = (f32x2){hr, hi};
}

template <bool OUT>
__device__ __forceinline__ void s5m_item(const Ctx& a, int layer, int item, LAS unsigned char* wl, int lane) {
    unsigned char* ws = a.ws;
    const int g = item & 15, sc = (item >> 4) & 15, b = item >> 8;
    const bf16_t* Z = (const bf16_t*)(ws + WS_Z);
    bf16_t* ACT = (bf16_t*)(ws + WS_ACT5);
    const float* P = (const float*)(ws + SM_S5P) + ((size_t)(layer * 16 + g) * 64 + lane) * 4;
    const float lbr = P[0], lbi = P[1], lsr = P[2], lsi = P[3];
    const int fr = lane & 15, fq = lane >> 4;
    const bf16x8 zero8 = (bf16x8){0, 0, 0, 0, 0, 0, 0, 0};
    bf16x8 bfr[8];
    { const float* bbg = (const float*)(ws + SM_BB) + (size_t)(layer * 16 + g) * 64 * 32;
#pragma unroll
      for (int j = 0; j < 8; ++j) { bfr[j] = zero8;
          if (fq < 2) { const float* src = bbg + (16 * (j & 3) + fr) * 32 + (j >= 4 ? 16 : 0) + 8 * fq; const f32x4 x0 = *(const f32x4*)src, x1 = *(const f32x4*)(src + 4);
              u32x4 w; w.x = pk2(x0[0], x0[1]); w.y = pk2(x0[2], x0[3]); w.z = pk2(x1[0], x1[1]); w.w = pk2(x1[2], x1[3]); bfr[j] = __builtin_bit_cast(bf16x8, w); } } }
    float* S5L = (float*)(ws + SM_S5L);
    float hr = 0.f, hi = 0.f;
    if (OUT) for (int j = 0; j < sc; ++j) { const f32x2 lc = *(const f32x2*)(S5L + ((size_t)((b * 16 + j) * 16 + g) * 64 + lane) * 2);
        const float nr = lsr * hr - lsi * hi + lc[0], ni = lsr * hi + lsi * hr + lc[1]; hr = nr; hi = ni; }
    LAS bf16_t* BU = (LAS bf16_t*)wl; LAS bf16_t* hb = (LAS bf16_t*)wl;
    bf16x8 cf[4]; float dval = 0.f;
    if (OUT) { const bf16_t* cm = (const bf16_t*)(ws + SM_CM) + ((size_t)(layer * 16 + g) * 16 + fr) * 128;
#pragma unroll
        for (int ks = 0; ks < 4; ++ks) cf[ks] = *(const bf16x8*)(cm + 32 * ks + 8 * fq);
        dval = a.in(I_S5D)[layer * 256 + 16 * g + fr]; }
    const size_t tok0 = (size_t)b * SEQ + (size_t)sc * 512;
    const bf16_t* zu = Z + tok0 * INC + 2560 + 16 * g;
    const u32x4 zero4 = (u32x4){0u, 0u, 0u, 0u};
    float one = 1.f; asm volatile("" : "+v"(one));
    u32x4 au = zero4;
    if (fq < 2) au = *(const u32x4*)(zu + (size_t)fr * INC + 8 * fq);
#pragma unroll 1
    for (int sub = 0; sub < 32; ++sub) {
        const bf16x8 afr = __builtin_bit_cast(bf16x8, au);
        if (OUT && fq < 2) { LAS float* up_ = (LAS float*)(wl + 4352) + fr * 16 + 8 * fq;
            *(LAS f32x4*)up_ = (f32x4){bflo(au.x), bfhi(au.x), bflo(au.y), bfhi(au.y)}; *(LAS f32x4*)(up_ + 4) = (f32x4){bflo(au.z), bfhi(au.z), bflo(au.w), bfhi(au.w)}; }
        if (sub + 1 < 32 && fq < 2) au = *(const u32x4*)(zu + (size_t)((sub + 1) * 16 + fr) * INC + 8 * fq);
        f32x4 bacc[8];
#pragma unroll
        for (int j = 0; j < 8; ++j) { bacc[j] = (f32x4){0.f, 0.f, 0.f, 0.f}; bacc[j] = __builtin_amdgcn_mfma_f32_16x16x32_bf16(afr, bfr[j], bacc[j], 0, 0, 0); }
#pragma unroll
        for (int j = 0; j < 8; ++j) { const f32x4 bs = bacc[j] * one; u32x2 w; w.x = pk2(bs[0], bs[1]); w.y = pk2(bs[2], bs[3]); *(LAS u32x2*)(BU + (16 * j + fr) * 16 + 4 * fq) = w; }
        LDS_FENCE();
        u32x4 rr[2], ri[2];
        rr[0] = *(const LAS u32x4*)(BU + lane * 16); rr[1] = *(const LAS u32x4*)(BU + lane * 16 + 8); ri[0] = *(const LAS u32x4*)(BU + (64 + lane) * 16); ri[1] = *(const LAS u32x4*)(BU + (64 + lane) * 16 + 8);
        LDS_FENCE();
#pragma unroll
        for (int t = 0; t < 16; ++t) {
            const unsigned wr_ = rr[t >> 3][(t >> 1) & 3], wi_ = ri[t >> 3][(t >> 1) & 3];
            const float br = (t & 1) ? bfhi(wr_) : bflo(wr_), bi = (t & 1) ? bfhi(wi_) : bflo(wi_);
            const float nr = lbr * hr - lbi * hi + br, ni = lbr * hi + lbi * hr + bi; hr = nr; hi = ni;
            if (OUT) { hb[t * 136 + lane] = f2bf(hr); hb[t * 136 + 64 + lane] = f2bf(hi); }
        }
        if (OUT) {
            LDS_FENCE();
            f32x4 acc = (f32x4){0.f, 0.f, 0.f, 0.f};
#pragma unroll
            for (int ks = 0; ks < 4; ++ks) { const bf16x8 av = *(const LAS bf16x8*)(hb + fr * 136 + 32 * ks + 8 * fq); acc = __builtin_amdgcn_mfma_f32_16x16x32_bf16(av, cf[ks], acc, 0, 0, 0); }
#pragma unroll
            for (int e = 0; e < 4; ++e) { const int tk = fq * 4 + e; const float uu = ((const LAS float*)(wl + 4352))[tk * 16 + fr]; const float y = acc[e] + dval * uu;
                ACT[(tok0 + sub * 16 + tk) * 256 + 16 * g + fr] = f2bf(gelu_t(y)); }
            LDS_FENCE();
        }
    }
    if (!OUT) *(f32x2*)(S5L + ((size_t)((b * 16 + sc) * 16 + g) * 64 + lane) * 2) = (f32x2){hr, hi};
}

template <bool OUT>
__device__ __forceinline__ void lru_item(const Ctx& a, int layer, int item, int lane) {
    unsigned char* ws = a.ws;
    const int cg4 = item & 3, sc = (item >> 2) & 63, b = item >> 8;
    const int c = 64 * cg4 + lane;
    const bf16_t* G = (const bf16_t*)(ws + WS_LG); const bf16_t* XC = (const bf16_t*)(ws + WS_X); const bf16_t* Z = (const bf16_t*)(ws + WS_Z);
    bf16_t* YC = (bf16_t*)(ws + WS_P);
    float* LL = (float*)(ws + SM_LL);
    const float lam = a.in(I_LAM)[layer * 256 + c];
    const float la = -8.f * log1pf(__expf(-lam));
    float hst = 0.f, ap = 1.f;
    if (OUT) for (int j = 0; j < sc; ++j) { const f32x2 lc = *(const f32x2*)(LL + ((size_t)(b * 64 + j) * 256 + c) * 2); hst = lc[0] * hst + lc[1]; }
    const size_t tok0 = (size_t)b * SEQ + (size_t)sc * 128;
#pragma unroll 8
    for (int t = 0; t < 128; ++t) {
        const size_t tk = tok0 + t;
        const float rg = bf2f(G[tk * 512 + c]), ig = bf2f(G[tk * 512 + 256 + c]), xc = bf2f(XC[tk * 256 + c]);
        const float loga = rg * la; const float av = __expf(loga); const float x2 = 2.f * loga;
        const float m1 = (x2 > -0.1f) ? -x2 * (1.f + x2 * 0.5f * (1.f + x2 * (1.f / 3.f) * (1.f + x2 * 0.25f * (1.f + x2 * 0.2f)))) : 1.f - av * av;
        const float uu = sqrtf(m1) * ig * xc;
        hst = av * hst + uu; ap *= av;
        if (OUT) { const float xg = bf2f(Z[tk * INC + 2048 + c]); YC[tk * D + 512 + c] = f2bf(hst * gelu_t(xg)); }
    }
    if (!OUT) *(f32x2*)(LL + ((size_t)(b * 64 + sc) * 256 + c) * 2) = (f32x2){ap, hst};
}

__device__ __forceinline__ void prologue_phase(const Ctx& a, LAS unsigned char* lds, int tid, int lane, int wid, int bx, int G, int gw, int NGW) {
    unsigned char* ws = a.ws; float* X = (float*)a.in(39); bf16_t* H = (bf16_t*)(ws + WS_H);

            LAS float* scr = (LAS float*)(lds + wid * 8448);
            constexpr int C0 = 1408, C1 = C0 + 2048, C2 = C1 + 512, C6 = C2 + 512, C7 = C6 + 32, C8 = C7 + 512, C9 = C8 + 1024, C10 = C9 + 512, C11 = C10 + 2816, CT = C11 + 1408;
#pragma unroll 1
            for (int gi = gw; gi < NL * CT; gi += NGW) {
                const int l = gi / CT, r = gi % CT;
                unsigned char* wl = ws + WS_W + l * WL_STRIDE;
                const float* W; int ldw, K, N, mode = 0, it; bf16_t* WT;
                if (r < C0) { it = r; W = a.in(I_WIN) + (size_t)l * D * INC; ldw = INC; K = D; N = INC; WT = (bf16_t*)(wl + OW_IN); }
                else if (r < C1) { it = r - C0; W = a.in(I_WGATE) + (size_t)l * D * 4096; ldw = 4096; K = D; N = 4096; WT = (bf16_t*)(wl + OW_GATE); mode = 1; }
                else if (r < C2) { const int q = r - C1, nb = q >> 7; it = q & 127; W = a.in(I_WUP) + ((size_t)l * 4 + nb) * 256 * D; ldw = D; K = 256; N = D; WT = (bf16_t*)(wl + OW_UP) + (size_t)nb * 1024 * 256; }
                else if (r < C6) { it = r - C2; W = a.in(I_WOUT) + (size_t)l * D * D; ldw = D; K = D; N = D; WT = (bf16_t*)(wl + OW_OUT); }
                else if (r < C7) { it = r - C6; W = a.in(I_GLUW) + (size_t)l * 256 * 256; ldw = 256; K = 256; N = 256; WT = (bf16_t*)(wl + OW_GLU); }
                else if (r < C8) { it = r - C7; W = a.in(I_WQ) + (size_t)l * D * D; ldw = D; K = D; N = D; WT = (bf16_t*)(wl + OW_Q); }
                else if (r < C9) { it = r - C8; W = a.in(I_WKV) + (size_t)l * D * 2048; ldw = 2048; K = D; N = 2048; WT = (bf16_t*)(wl + OW_KV); }
                else if (r < C10) { it = r - C9; W = a.in(I_WO) + (size_t)l * D * D; ldw = D; K = D; N = D; WT = (bf16_t*)(wl + OW_O); }
                else if (r < C11) { it = r - C10; W = a.in(I_WGU) + (size_t)l * D * 2 * FF; ldw = 2 * FF; K = D; N = 2 * FF; WT = (bf16_t*)(wl + OW_GU); mode = 2; }
                else { it = r - C11; W = a.in(I_WDOWN) + (size_t)l * FF * D; ldw = D; K = FF; N = D; WT = (bf16_t*)(wl + OW_DOWN); }
                transpose_item(W, ldw, K, N, WT, mode, scr, it, lane);
            }
            const int NT = G * 512, gt = NT - 1 - (bx * 512 + tid);
            for (int i = gt; i < NL * 512 * 256; i += NT) { const int l = i / (512 * 256), rem = i % (512 * 256), n = rem >> 8, k = rem & 255, ch = n & 255, blk = ch >> 6;
                float v = 0.f; if ((k >> 6) == blk) v = a.in(n < 256 ? I_WA : I_WX)[((size_t)(l * 4 + blk) * 64 + (k & 63)) * 64 + (ch & 63)];
                ((bf16_t*)(ws + WS_W + l * WL_STRIDE + OW_LRU))[rem] = f2bf(v); }
            for (int i = gt; i < NL * 512; i += NT) { const int l = i >> 9, n = i & 511; ((float*)(ws + SM_LB))[i] = a.in(n < 256 ? I_BA : I_BX)[l * 256 + (n & 255)]; }
            for (int i = gt; i < SEQ * 32; i += NT) { const int pos = i >> 5, f = i & 31; const double inv = exp2(-(double)f * (13.287712379549449 / 32.0)); float s, c; sincos_acc((double)pos * inv, s, c);
                ((float*)(ws + SM_COS))[i] = c; ((float*)(ws + SM_SIN))[i] = s; }
            for (int i = gt; i < NL * 16 * 64; i += NT) { const int l = i >> 10, g = (i >> 6) & 15;
                const float lre = a.in(I_S5LRE)[i], lim = a.in(I_S5LIM)[i]; const float step = expf(a.in(I_S5LDT)[l * 16 + g]);
                const float mag = expf(lre * step); float s, c; sincos_acc((double)(lim * step), s, c);
                const float lbr = mag * c, lbi = mag * s; const float den = lre * lre + lim * lim;
                const float fre = ((lbr - 1.f) * lre + lbi * lim) / den, fim = (lbi * lre - (lbr - 1.f) * lim) / den;
                const float magS = expf(512.f * lre * step); float s2, c2; sincos_acc(512.0 * (double)(lim * step), s2, c2);
                float* P = (float*)(ws + SM_S5P) + (size_t)i * 4; P[0] = lbr; P[1] = lbi; P[2] = magS * c2; P[3] = magS * s2;
                float* bb = (float*)(ws + SM_BB) + (size_t)i * 32;
                for (int p = 0; p < 16; ++p) { const float bre = a.in(I_S5BRE)[(size_t)i * 16 + p], bim = a.in(I_S5BIM)[(size_t)i * 16 + p]; bb[p] = fre * bre - fim * bim; bb[16 + p] = fre * bim + fim * bre; } }
            for (int i = gt; i < NL * 16 * 16 * 128; i += NT) { const int k = i & 127, lgp = i >> 7;
                const float v = (k < 64) ? a.in(I_S5CRE)[(size_t)lgp * 64 + k] : -a.in(I_S5CIM)[(size_t)lgp * 64 + (k - 64)];
                ((bf16_t*)(ws + SM_CM))[i] = f2bf(v); }
            for (int l = 0; l < NL; ++l) addnorm_rows<false, false>(a.in(I_MEM), nullptr, nullptr, nullptr, a.in(I_NMEM) + l * D, (bf16_t*)(ws + SM_MN) + (size_t)l * 2048 * D, 2048, gw, NGW, lane);
            addnorm_rows<false, true>(a.in(I_X), (bf16_t*)(ws + WS_XB), nullptr, nullptr, a.in(I_NMIXPRE), H, T, gw, NGW, lane);
}

#define XB_TMO      128
#define XB_XCNT(j)  (256  + 64 * (j))
#define XB_XSUB(j)  (1280 + 64 * (j))
#define XB_XGEN(j)  (2304 + 64 * (j))
#define XB_TOP      3328
#define XB_TOPGEN   3392
#define XCD_BAR_WORDS 3456
#define XB_SPIN_CAP (1u << 18)

__device__ __forceinline__ unsigned xb_ld(unsigned* p)              { return __hip_atomic_load(p, __ATOMIC_RELAXED, __HIP_MEMORY_SCOPE_AGENT); }
__device__ __forceinline__ unsigned xb_add(unsigned* p, unsigned v) { return __hip_atomic_fetch_add(p, v, __ATOMIC_RELAXED, __HIP_MEMORY_SCOPE_AGENT); }
__device__ __forceinline__ unsigned xb_xcc_id() { return (unsigned)__builtin_amdgcn_s_getreg((3 << 11) | 20) & 0xFu; }
#define XB_SPIN(cond, bar) do { unsigned _sp = 0; while (cond) { __builtin_amdgcn_s_sleep(1); \
    if ((++_sp & 255u) == 0u) { if (xb_ld(&(bar)[XB_TMO])) break; if (_sp > XB_SPIN_CAP) { atomicAdd(&(bar)[XB_TMO], 1u); break; } } } } while (0)

struct XcdBarrier {
    unsigned* bar; unsigned x;
    volatile LAS unsigned* st;
};

__device__ __forceinline__ XcdBarrier xcd_barrier_post(unsigned* bar, volatile LAS unsigned* st) {
    XcdBarrier b; b.bar = bar; b.x = xb_xcc_id(); b.st = st;
    if (threadIdx.x == 0) (void)xb_add(&bar[XB_XCNT(b.x)], 1u);
    return b;
}
__device__ __forceinline__ void xcd_barrier_complete(unsigned* bar, unsigned x, unsigned& nloc, unsigned& nx) {
    const unsigned G = gridDim.x * gridDim.y * gridDim.z;
    unsigned sum, cnt, mine, sp = 0u;
    for (;;) {
        sum = 0u; cnt = 0u; mine = 0u;
#pragma unroll
        for (unsigned j = 0; j < 16; ++j) { const unsigned c = xb_ld(&bar[XB_XCNT(j)]); sum += c; cnt += (c > 0u) ? 1u : 0u; mine = (j == x) ? c : mine; }
        if (sum == G) break;
        __builtin_amdgcn_s_sleep(1);
        if ((++sp & 255u) == 0u) { if (xb_ld(&bar[XB_TMO])) break; if (sp > XB_SPIN_CAP) { atomicAdd(&bar[XB_TMO], 1u); break; } }
    }
    nloc = mine > 0u ? mine : 1u; nx = cnt > 0u ? cnt : 1u;
}

__device__ __forceinline__ void xcd_barrier(const XcdBarrier& b) {
    asm volatile("s_waitcnt vmcnt(0)" ::: "memory");
    __syncthreads();
    if (threadIdx.x == 0) {
        unsigned* bar = b.bar;
        __builtin_amdgcn_s_waitcnt(0);
        unsigned nloc = b.st[0], nx = b.st[1];
        if (nloc == 0u) { xcd_barrier_complete(bar, b.x, nloc, nx); b.st[0] = nloc; b.st[1] = nx; }
        const unsigned old = xb_add(&bar[XB_XSUB(b.x)], 1u);
        const unsigned gen = old / nloc;
        if (old + 1u == (gen + 1u) * nloc) {
            __builtin_amdgcn_fence(__ATOMIC_RELEASE, "agent");
            asm volatile("s_waitcnt vmcnt(0)" ::: "memory");
            const unsigned og = xb_add(&bar[XB_TOP], 1u);
            const unsigned tg = og / nx;
            if (og + 1u == (tg + 1u) * nx) xb_add(&bar[XB_TOPGEN], 1u);
            else XB_SPIN(xb_ld(&bar[XB_TOPGEN]) == tg, bar);
            __builtin_amdgcn_fence(__ATOMIC_ACQUIRE, "agent");
            xb_add(&bar[XB_XGEN(b.x)], 1u);
            asm volatile("s_waitcnt vmcnt(0)" ::: "memory");
        } else {
            XB_SPIN(xb_ld(&bar[XB_XGEN(b.x)]) == gen, bar);
            __builtin_amdgcn_fence(__ATOMIC_ACQUIRE, "agent");
            asm volatile("s_waitcnt vmcnt(0)" ::: "memory");
        }
    }
    __syncthreads();
}

__global__ void __launch_bounds__(512, 2) mega(Args kargs) {
    extern __shared__ __attribute__((aligned(16))) unsigned char lds_raw[];
    LAS unsigned char* lds = (LAS unsigned char*)lds_raw;
    LAS unsigned long long* ptw = (LAS unsigned long long*)(lds + LDS_BYTES);
    if (threadIdx.x == 0) {
#pragma unroll
        for (int i = 0; i < 39; ++i) ptw[i] = (unsigned long long)kargs.in[i];
        ptw[39] = (unsigned long long)kargs.out; ptw[40] = (unsigned long long)kargs.ws;
        ((LAS unsigned*)(lds + LDS_BYTES + 384))[0] = 0u; ((LAS unsigned*)(lds + LDS_BYTES + 384))[1] = 0u;
    }
    __syncthreads();
    const int ph_lo = kargs.ph_lo, ph_hi = kargs.ph_hi;
    if (ph_lo >= 100) {
        const float* src = (const float*)((unsigned char*)kargs.ws + WS_Z); const bf16_t* srcb = (const bf16_t*)((unsigned char*)kargs.ws + (ph_lo == 101 ? WS_Q : (ph_lo == 102 ? WS_P : (ph_lo == 104 ? WS_H : (ph_lo == 105 ? WS_Z : SM_KM)))));
        for (size_t i = (size_t)blockIdx.x * 512 + threadIdx.x; i < (size_t)T * D; i += (size_t)gridDim.x * 512) kargs.out[i] = (ph_lo == 100) ? src[i] : ((ph_lo == 103 && i >= (size_t)4 * 1024 * 1024) ? 0.f : 64.f * bf2f(srcb[i]));
        return;
    }
    if (ph_lo == 0) {
        int tid = threadIdx.x; asm volatile("" : "+v"(tid));
        Ctx a; a.pt = ptw; a.ws = (unsigned char*)a.in(40);
        const int lane = tid & 63, wid = __builtin_amdgcn_readfirstlane(tid >> 6);
        const int G = gridDim.x, bx = blockIdx.x;
        if (bx == 0) for (int i = tid; i < XCD_BAR_WORDS; i += 512) ((unsigned*)(a.ws + WS_CTL))[i] = 0u;
        if (PEN(31)) prologue_phase(a, lds, tid, lane, wid, bx, G, bx * 8 + wid, G * 8);
        if (ph_hi > 1) { __syncthreads(); cg::this_grid().sync(); }
    }
    XcdBarrier xbar = xcd_barrier_post((unsigned*)((unsigned char*)kargs.ws + WS_CTL), (volatile LAS unsigned*)(lds + LDS_BYTES + 384));
#pragma unroll 1
    for (int ph = (ph_lo > 1 ? ph_lo : 1); ph < ph_hi; ++ph) {
        int tid = threadIdx.x; asm volatile("" : "+v"(tid));
        Ctx a; a.pt = ptw; a.ws = (unsigned char*)a.in(40);
        unsigned char* ws = a.ws;
        const int lane = tid & 63, wid = __builtin_amdgcn_readfirstlane(tid >> 6);
        int G = gridDim.x, bx = blockIdx.x; asm volatile("" : "+s"(G), "+s"(bx));
        const int gw = bx * 8 + wid, NGW = G * 8;
        float* X = (float*)a.in(39);
        bf16_t* H = (bf16_t*)(ws + WS_H); bf16_t* Zb = (bf16_t*)(ws + WS_Z); bf16_t* Qb = (bf16_t*)(ws + WS_Q); bf16_t* Xb = (bf16_t*)(ws + WS_X); bf16_t* Pb = (bf16_t*)(ws + WS_P);
        {
            const int l = (ph - 1) / NSUB, sp = SPSEQ[(ph - 1) % NSUB];
            unsigned char* wl = ws + WS_W + l * WL_STRIDE;
            using pg8::GS;
            switch (sp) {
            case 0: if (PEN(0)) {
                pg8::EpiBf16<0, INC> E{Zb, nullptr, nullptr}; pg8::gemm_phase<GS<T, INC, D, D, D>>(tid, lds, H, (const bf16_t*)(wl + OW_IN), bx, E);
            } break;
            case 1: if (PEN(1)) {
                if (wid < 4) { if (PEN(23)) gla_item<false>(a, l, bx * 4 + wid, lds + wid * GL_BYTES, lane); }
                else {
                    const int w4 = bx * 4 + (wid - 4);
                    if (PEN(24)) {
                    const float* cw = a.in(I_CONVW) + l * 4 * 256; const float* cb = a.in(I_CONVB) + l * 256;
                    for (int v = w4 * 64 + lane; v < T * 32; v += G * 4 * 64) {
                        const int t = v >> 5, c8 = (v & 31) * 8, s = t & (SEQ - 1);
                        float acc[8];
#pragma unroll
                        for (int i = 0; i < 8; ++i) acc[i] = cb[c8 + i];
#pragma unroll
                        for (int j = 0; j < 4; ++j) { if (s - 3 + j >= 0) { const u32x4 w = *(const u32x4*)(Zb + (size_t)(t - 3 + j) * INC + 2304 + c8); const float* wj = cw + j * 256 + c8;
                            acc[0] += wj[0] * bflo(w.x); acc[1] += wj[1] * bfhi(w.x); acc[2] += wj[2] * bflo(w.y); acc[3] += wj[3] * bfhi(w.y);
                            acc[4] += wj[4] * bflo(w.z); acc[5] += wj[5] * bfhi(w.z); acc[6] += wj[6] * bflo(w.w); acc[7] += wj[7] * bfhi(w.w); } }
                        u32x4 o; o.x = pk2(acc[0], acc[1]); o.y = pk2(acc[2], acc[3]); o.z = pk2(acc[4], acc[5]); o.w = pk2(acc[6], acc[7]);
                        *(u32x4*)(Xb + (size_t)t * 256 + c8) = o;
                    } }
                }
                s5m_item<false>(a, l, bx * 8 + wid, wid < 4 ? lds + wid * GL_BYTES : lds + S5_OFF + (wid - 4) * S5_BYTES, lane);
            } break;
            case 2: if (PEN(2)) {
                if (PEN(20)) { pg8::EpiBf16<1, 512> E{(bf16_t*)(ws + WS_LG), (const float*)(ws + SM_LB) + l * 512, nullptr};
                  pg8::gemm_phase<GS<T, 512, 256, 256, 256>>(tid, lds, Xb, (const bf16_t*)(wl + OW_LRU), bx, E); }
                float* SLOC = (float*)(ws + SM_SLOC); const float* DTOT = (const float*)(ws + SM_DTOT);
                for (int v = bx * 512 + tid; v < 64 * 4096; v += G * 512) {
                    const int e = v & 4095, combo = v >> 12, hh = combo & 3, mx = (combo >> 2) & 1, b = combo >> 3;
                    float st = 0.f;
#pragma unroll 4
                    for (int j = 0; j < 16; ++j) { const int itj = (b << 7) | (j << 3) | (mx << 2) | hh; float* p = SLOC + (size_t)itj * 4096 + e; const float loc = *p; const float dd = DTOT[(size_t)itj * 64 + (e >> 6)];
                        *p = st; st = dd * st + loc; }
                }
            } break;
            case 3: if (PEN(3)) {
                if (wid < 4) { if (PEN(21)) gla_item<true>(a, l, bx * 4 + wid, lds + wid * GL_BYTES, lane); }
                else { lru_item<false>(a, l, bx * 4 + (wid - 4), lane); lru_item<false>(a, l, 1024 + bx * 4 + (wid - 4), lane); }
                s5m_item<true>(a, l, bx * 8 + wid, wid < 4 ? lds + wid * GL_BYTES : lds + S5_OFF + (wid - 4) * S5_BYTES, lane);
            } break;
            case 4: if (PEN(4)) {
                { pg8::EpiBf16<2, D, 256> E{Pb + 768, a.in(I_GLUB) + l * 256, (const bf16_t*)(ws + WS_ACT5)};
                  pg8::gemm_phase<GS<T, 256, 256, 256, 256>>(tid, lds, (const bf16_t*)(ws + WS_ACT5), (const bf16_t*)(wl + OW_GLU), bx, E); }
                { pg8::EpiBf16<3, D> E{(bf16_t*)(ws + SM_KM), nullptr, nullptr};
                  pg8::gemm_phase<GS<2048, 1024, D, D, D>>(tid, lds, (const bf16_t*)(ws + SM_MN) + (size_t)l * 2048 * D, (const bf16_t*)(wl + OW_KV), bx, E); }
                { pg8::EpiBf16<0, 2048> E{(bf16_t*)(ws + SM_VT), nullptr, nullptr};
                  pg8::gemm_phase<GS<1024, 2048, D, D, D>>(tid, lds, (const bf16_t*)(wl + OW_KV) + (size_t)1024 * D, (const bf16_t*)(ws + SM_MN) + (size_t)l * 2048 * D, (bx + 128) & 255, E); }
                lru_item<true>(a, l, gw, lane);
            } break;
            case 5: if (PEN(5)) { lru_item<true>(a, l, gw, lane); } break;
            case 6: if (PEN(6)) {
                pg8::EpiBf16<0, 4096> E{Zb, nullptr, nullptr}; pg8::gemm_phase<GS<T, 4096, 256, D, 256, 4, 256>>(tid, lds, Pb, (const bf16_t*)(wl + OW_UP), bx, E);
            } break;
            case 7: if (PEN(7)) {
                pg8::EpiMix E{Pb, a.in(I_BGATE) + l * 4096, Zb}; pg8::gemm_phase<GS<T, 4096, D, D, D>>(tid, lds, H, (const bf16_t*)(wl + OW_GATE), bx, E);
            } break;
            case 8: if (PEN(8)) {
                pg8::EpiBf16<0, D> E{H, nullptr, nullptr}; pg8::gemm_phase<GS<T, D, D, D, D>>(tid, lds, Pb, (const bf16_t*)(wl + OW_OUT), bx, E);
            } break;
            case 9: if (PEN(9)) addnorm_rows<true, true>(ws + WS_XB, ws + WS_XB, H, a.in(I_NMIXPOST) + l * D, a.in(I_NXAPRE) + l * D, H, T, gw, NGW, lane); break;
            case 10: if (PEN(10)) {
                pg8::EpiBf16<0, D> E{Pb, nullptr, nullptr}; pg8::gemm_phase<GS<T, D, D, D, D>>(tid, lds, H, (const bf16_t*)(wl + OW_Q), bx, E);
            } break;
            case 11: if (PEN(11)) {
                pg8::EpiBf16<0, D> E{Zb, nullptr, nullptr}; pg8::gemm_phase<GS<T, D, 256, D, D, 1, 256, 256, 32, 256L * D>>(tid, lds, Pb, (const bf16_t*)(ws + SM_KM), bx, E);
            } break;
            case 12: if (PEN(12)) {
                for (int row0 = gw; row0 < T; row0 += 2 * NGW) {
                    u32x2 sw[2][4];
#pragma unroll
                    for (int u = 0; u < 2; ++u) { const u32x2* sr = (const u32x2*)(Zb + (size_t)(row0 + u * NGW) * D) + lane;
#pragma unroll
                        for (int j = 0; j < 4; ++j) sw[u][j] = sr[64 * j]; }
#pragma unroll
                    for (int u = 0; u < 2; ++u) { u32x2* pw = (u32x2*)(Qb + (size_t)(row0 + u * NGW) * D) + lane;
#pragma unroll
                        for (int j = 0; j < 4; ++j) { f32x4 v = (f32x4){bflo(sw[u][j].x), bfhi(sw[u][j].x), bflo(sw[u][j].y), bfhi(sw[u][j].y)}; const float mx = wave_max(fmaxf(fmaxf(v[0], v[1]), fmaxf(v[2], v[3])));
                            v[0] = __expf(v[0] - mx); v[1] = __expf(v[1] - mx); v[2] = __expf(v[2] - mx); v[3] = __expf(v[3] - mx);
                            const float inv = 1.f / wave_sum((v[0] + v[1]) + (v[2] + v[3])); u32x2 w; w.x = pk2(v[0] * inv, v[1] * inv); w.y = pk2(v[2] * inv, v[3] * inv); pw[64 * j] = w; } }
                }
            } break;
            case 13: if (PEN(13)) {
                pg8::EpiBf16<0, D> E{Pb, nullptr, nullptr}; pg8::gemm_phase<GS<T, D, 256, D, 2048, 1, 256, -1, 32, 256>>(tid, lds, Qb, (const bf16_t*)(ws + SM_VT), bx, E);
            } break;
            case 14: if (PEN(14)) {
                pg8::EpiBf16<0, D> E{H, nullptr, nullptr}; pg8::gemm_phase<GS<T, D, D, D, D>>(tid, lds, Pb, (const bf16_t*)(wl + OW_O), bx, E);
            } break;
            case 15: if (PEN(15)) addnorm_rows<true, true>(ws + WS_XB, ws + WS_XB, H, a.in(I_NXAPOST) + l * D, a.in(I_NFFNPRE) + l * D, H, T, gw, NGW, lane); break;
            case 16: if (PEN(16)) {
                pg8::EpiGU E{Zb}; pg8::gemm_phase<GS<T, 2 * FF, D, D, D>>(tid, lds, H, (const bf16_t*)(wl + OW_GU), bx, E);
            } break;
            case 17: if (PEN(17)) {
                pg8::EpiBf16<0, D> E{H, nullptr, nullptr}; pg8::gemm_phase<GS<T, D, FF, FF, FF>>(tid, lds, Zb, (const bf16_t*)(wl + OW_DOWN), bx, E);
            } break;
            default:
                if (l + 1 < NL) addnorm_rows<true, true>(ws + WS_XB, ws + WS_XB, H, a.in(I_NFFNPOST) + l * D, a.in(I_NMIXPRE) + (l + 1) * D, H, T, gw, NGW, lane);
                else addnorm_rows<true, false>(ws + WS_XB, X, H, a.in(I_NFFNPOST) + l * D, nullptr, nullptr, T, gw, NGW, lane);
                break;
            }
        }
        if (ph + 1 < ph_hi) xcd_barrier(xbar);
    }
    if (DUMPPH >= 200) {
        __syncthreads(); cg::this_grid().sync();
        unsigned char* ws = (unsigned char*)kargs.ws; float* out = kargs.out;
        const size_t gt = (size_t)blockIdx.x * 512 + threadIdx.x, NT = (size_t)gridDim.x * 512;
        for (size_t i = gt; i < (size_t)T * D; i += NT) out[i] = 0.f;
        __syncthreads(); cg::this_grid().sync();
        if (DUMPPH == 201) {
            const bf16_t* H = (const bf16_t*)(ws + WS_H); const bf16_t* Z = (const bf16_t*)(ws + WS_Z); const float* W = kargs.in[I_WIN];
            const size_t s = gt; const int row = (int)((s * 7919u) % T), col = (int)((s * 104729u + 13u) % INC);
            float dot = 0.f; for (int k = 0; k < D; ++k) dot += bf2f(H[(size_t)row * D + k]) * W[(size_t)k * INC + col];
            out[s] = 1e4f * fabsf(dot - bf2f(Z[(size_t)row * INC + col]));
        }
        if (DUMPPH == 206) {
            const bf16_t* YC = (const bf16_t*)(ws + WS_P); const bf16_t* UP = (const bf16_t*)(ws + WS_Z); const float* W = kargs.in[I_WUP];
            const size_t s = gt; const int row = (int)((s * 7919u) % T), col = (int)((s * 104729u + 13u) % 4096), nb = col >> 10, c = col & 1023;
            float dot = 0.f; for (int k = 0; k < 256; ++k) dot += bf2f(YC[(size_t)row * D + nb * 256 + k]) * W[((size_t)nb * 256 + k) * D + c];
            out[s] = ENC(fabsf(dot - bf2f(UP[(size_t)row * 4096 + col])));
        }
        if (DUMPPH == 207) {
            const bf16_t* XC = (const bf16_t*)(ws + WS_X); const bf16_t* GG = (const bf16_t*)(ws + WS_LG);
            const size_t s = gt; const int row = (int)((s * 7919u) % T), col = (int)((s * 104729u + 13u) % 512), ch = col & 255, blk = ch >> 6;
            const float* wsel = kargs.in[col < 256 ? I_WA : I_WX] + (size_t)blk * 4096;
            float dot = kargs.in[col < 256 ? I_BA : I_BX][ch]; for (int i = 0; i < 64; ++i) dot += bf2f(XC[(size_t)row * 256 + 64 * blk + i]) * wsel[i * 64 + (ch & 63)];
            out[s] = ENC(fabsf(1.f / (1.f + expf(-dot)) - bf2f(GG[(size_t)row * 512 + col])));
        }
        if (DUMPPH == 208) {
            const bf16_t* GG = (const bf16_t*)(ws + WS_LG); float cnt = 0.f;
            for (size_t i = gt; i < (size_t)T * 512; i += NT) cnt += (fabsf(bf2f(GG[i])) > 1.5f) ? 1.f : 0.f;
            out[gt] = ENC(cnt);
        }
        if (DUMPPH == 202 && gt < 2048) {
            const int l = 0, b = (int)gt >> 8, c = (int)gt & 255, blk = c >> 6, cj = c & 63;
            const bf16_t* Z = (const bf16_t*)(ws + WS_Z); const bf16_t* XC = (const bf16_t*)(ws + WS_X); const bf16_t* YC = (const bf16_t*)(ws + WS_P);
            const float* cw = kargs.in[I_CONVW] + l * 1024; const float cbv = kargs.in[I_CONVB][l * 256 + c];
            const float* wa = kargs.in[I_WA] + (size_t)(l * 4 + blk) * 4096; const float* wx = kargs.in[I_WX] + (size_t)(l * 4 + blk) * 4096;
            const float bav = kargs.in[I_BA][l * 256 + c], bxv = kargs.in[I_BX][l * 256 + c];
            const float la = -8.f * log1pf(expf(-kargs.in[I_LAM][l * 256 + c]));
            float h = 0.f, md = 0.f, mdc = 0.f;
            for (int t = 0; t < SEQ; ++t) {
                const size_t tk = (size_t)b * SEQ + t;
                float xc = cbv; for (int j = 0; j < 4; ++j) if (t - 3 + j >= 0) xc += cw[j * 256 + c] * bf2f(Z[(tk - 3 + j) * INC + 2304 + c]);
                float ra = bav, rx = bxv; for (int i = 0; i < 64; ++i) { const float xv = bf2f(XC[tk * 256 + 64 * blk + i]); ra += xv * wa[i * 64 + cj]; rx += xv * wx[i * 64 + cj]; }
                const float r = 1.f / (1.f + expf(-ra)), ig = 1.f / (1.f + expf(-rx));
                { const bf16_t* GG = (const bf16_t*)(ws + WS_LG); mdc += (fabsf(bf2f(GG[tk * 512 + c])) > 1.5f) ? 1.f : 0.f; }
                const float loga = la * r; const float av = expf(loga); const float uu = sqrtf(-expm1f(2.f * loga)) * ig * xc;
                h = av * h + uu;
                const float xg = bf2f(Z[tk * INC + 2048 + c]); const float u3 = 0.7978845608f * (xg + 0.044715f * xg * xg * xg); const float ge = 0.5f * xg * (1.f + tanhf(u3));
                md = fmaxf(md, fabsf(h * ge - bf2f(YC[tk * D + 512 + c])));
            }
            out[gt] = ENC(mdc); out[4096 + gt] = 0.01f * ENC(md);
        }
        if (DUMPPH == 203 && gt < 128 * 64) {
            const int l = 0, wv = (int)(gt >> 6), lane = (int)gt & 63, b = wv >> 4, g = wv & 15;
            const bf16_t* Z = (const bf16_t*)(ws + WS_Z); const bf16_t* ACT = (const bf16_t*)(ws + WS_ACT5);
            const int pi = (l * 16 + g) * 64 + lane;
            const float lre = kargs.in[I_S5LRE][pi], lim = kargs.in[I_S5LIM][pi], step = expf(kargs.in[I_S5LDT][l * 16 + g]);
            const float mag = expf(lre * step); float sn, cs; sincos_acc((double)(lim * step), sn, cs);
            const float lbr = mag * cs, lbi = mag * sn, den = lre * lre + lim * lim;
            const float fre = ((lbr - 1.f) * lre + lbi * lim) / den, fim = (lbi * lre - (lbr - 1.f) * lim) / den;
            float hr = 0.f, hi = 0.f, md = 0.f;
            for (int t = 0; t < SEQ; ++t) {
                const size_t tk = (size_t)b * SEQ + t;
                float br = 0.f, bi = 0.f;
                for (int p = 0; p < 16; ++p) { const float u = bf2f(Z[tk * INC + 2560 + 16 * g + p]); const float bre = kargs.in[I_S5BRE][(size_t)pi * 16 + p], bim = kargs.in[I_S5BIM][(size_t)pi * 16 + p];
                    br += (fre * bre - fim * bim) * u; bi += (fre * bim + fim * bre) * u; }
                const float nr = lbr * hr - lbi * hi + br, ni = lbr * hi + lbi * hr + bi; hr = nr; hi = ni;
                for (int p = 0; p < 16; ++p) { const size_t ci = ((size_t)(l * 16 + g) * 16 + p) * 64 + lane;
                    float y = wave_sum(kargs.in[I_S5CRE][ci] * hr - kargs.in[I_S5CIM][ci] * hi);
                    const float u = bf2f(Z[tk * INC + 2560 + 16 * g + p]); y += kargs.in[I_S5D][l * 256 + 16 * g + p] * u;
                    const float u3 = 0.7978845608f * (y + 0.044715f * y * y * y); const float ge = 0.5f * y * (1.f + tanhf(u3));
                    md = fmaxf(md, fabsf(ge - bf2f(ACT[tk * 256 + 16 * g + p]))); }
            }
            if (lane == 0) out[wv] = ENC(md);
        }
        if ((DUMPPH == 204 || DUMPPH == 205) && gt < 64 * 64) {
            const int l = 0, wv = (int)(gt >> 6), lane = (int)gt & 63, hh = wv & 3, mx = (wv >> 2) & 1, b = wv >> 3;
            const bf16_t* Z = (const bf16_t*)(ws + WS_Z); const bf16_t* YC = (const bf16_t*)(ws + WS_P);
            const int cq = (mx ? 1024 : 0) + 64 * hh;
            const float lgam = log1pf(-exp2f(-5.f - (float)hh));
            float S[64];
#pragma unroll
            for (int i = 0; i < 64; ++i) S[i] = 0.f;
            float md = 0.f;
            const float* gn = kargs.in[mx ? I_RETNORM : I_HGNORM] + l * 256 + 64 * hh;
            for (int t = 0; t < 2048; ++t) {
                const size_t tk = (size_t)b * SEQ + t; const bf16_t* zt = Z + tk * INC + cq;
                float q = bf2f(zt[lane]), fv = bf2f(zt[256 + lane]), f, kk;
                if (mx == 0) { f = 1.f / (1.f + expf(-fv)); kk = 1.f - f; q = q / (1.f + expf(-q)); }
                else { const double inv = exp2(-(double)(lane >> 1) * (13.287712379549449 / 32.0)); float sn, cs; sincos_acc((double)t * inv, sn, cs);
                    const float qp = __shfl_xor(q, 1), kp = __shfl_xor(fv, 1); const float sg = (lane & 1) ? sn : -sn; q = q * cs + qp * sg; kk = (fv * cs + kp * sg) * 0.125f; f = expf(lgam); }
                float ss = 0.f; float o[64];
#pragma unroll
                for (int dv = 0; dv < 64; ++dv) { const float v = bf2f(zt[512 + dv]); S[dv] = f * S[dv] + kk * v; o[dv] = wave_sum(q * S[dv]); ss += o[dv] * o[dv]; }
                const float rs = rsqrtf(ss * (1.f / 64.f) + EPS);
#pragma unroll
                for (int dv = 0; dv < 64; ++dv) { const float gg = bf2f(zt[768 + dv]); const float val = o[dv] * rs * gn[dv] * (gg / (1.f + expf(-gg)));
                    md = fmaxf(md, fabsf(val - bf2f(YC[tk * D + 256 * mx + 64 * hh + dv]))); }
            }
            if (lane == 0 && ((DUMPPH == 204) == (mx == 0))) out[wv] = ENC(md);
        }
    }
}

extern "C" void kernel_launch(void* const* d_in, const int* in_sizes, int n_in, void* d_out, int out_size, void* d_ws, size_t ws_size, hipStream_t stream) {
    static int ready = 0;
    if (!ready) {
        if (n_in != 39 || out_size != T * D || ws_size < WS_END + 128 * MiB) { fprintf(stderr, "kernel_launch: unexpected shapes (n_in %d out %d ws %zu)\n", n_in, out_size, ws_size); ready = -1; return; }
        if (hipFuncSetAttribute((const void*)mega, hipFuncAttributeMaxDynamicSharedMemorySize, LDS_BYTES + 512) != hipSuccess) { fprintf(stderr, "kernel_launch: hipFuncSetAttribute failed\n"); ready = -1; return; }
        ready = 1;
    }
    if (ready < 0) return;
    Args a{};
    for (int i = 0; i < 39; ++i) a.in[i] = (const float*)d_in[i];
    a.out = (float*)d_out; a.ws = (unsigned char*)d_ws;
#if PER_PHASE_LAUNCH
    for (int p = 0; p < (MAXPH < NPH ? MAXPH : NPH); ++p) { a.ph_lo = p; a.ph_hi = p + 1; hipLaunchKernelGGL(mega, dim3(256), dim3(512), LDS_BYTES + 512, stream, a); }
    if (DUMPPH) { a.ph_lo = DUMPPH; a.ph_hi = DUMPPH + 1; hipLaunchKernelGGL(mega, dim3(256), dim3(512), LDS_BYTES + 512, stream, a); }
#else
    a.ph_lo = 0; a.ph_hi = (MAXPH < NPH ? MAXPH : NPH);
    void* kargs[] = {&a};
    hipError_t e = hipLaunchCooperativeKernel((const void*)mega, dim3(256), dim3(512), kargs, LDS_BYTES + 512, stream);
    if (e != hipSuccess) fprintf(stderr, "cooperative launch failed: %s\n", hipGetErrorString(e));
#endif
}
```
